# Optimizing an MI355X kernel written in HIP

```python
import jax, jax.numpy as jnp
from jax import lax
import numpy as np

D_MODEL = 1024
BATCH = 16
SEQ = 2048
DEPTH = 4

N_MIXERS = 4
HEAD_DIM = 64
N_HEADS = D_MODEL // HEAD_DIM
SWA_KV_HEADS = 4
SWA_WINDOW = 128
SWA_BLOCK = 128
NSA_KV_GROUPS = 2
NSA_CMP_LEN = 32
NSA_CMP_STRIDE = 16
NSA_SEL_LEN = 64
NSA_TOPK = 8
NSA_WINDOW = 512
NSA_QBLOCK = 64
NSA_FORCE_BONUS = 1.0e4
GLA_HEADS = 4
GLA_DK = D_MODEL // 2
GLA_DV = D_MODEL
GLA_GATE_RANK = 16
GLA_TAU = 16.0
GLA_CHUNK = 64
POOL_WINDOWS = (2, 4, 8, 16)
POOL_GROUP = D_MODEL // 4
MEM_LEN = 256
XATTN_HEADS = 4
FFN_DIM = 2816
DN_ALPHA = (2 * DEPTH) ** 0.25
DN_BETA = (8 * DEPTH) ** -0.25
LN_EPS = 1e-5
NEG_INF = -1e30

SWA_IN = N_HEADS * HEAD_DIM + 2 * SWA_KV_HEADS * HEAD_DIM
NSA_IN = N_HEADS * HEAD_DIM + 6 * NSA_KV_GROUPS * HEAD_DIM + 3 * N_HEADS
GLA_IN = 2 * GLA_DK + 2 * GLA_DV + GLA_GATE_RANK

kernel_name = 'hybrid_interleaved_deepnorm_macaron_block'


def layer_norm(x, g, b):
    xf = x.astype(jnp.float32)
    mu = jnp.mean(xf, -1, keepdims=True)
    var = jnp.mean(jnp.square(xf - mu), -1, keepdims=True)
    return ((xf - mu) * lax.rsqrt(var + LN_EPS) * g + b).astype(x.dtype)


def alibi_slopes(n):
    return jnp.exp2(-8.0 * jnp.arange(1, n + 1, dtype=jnp.float32) / n)


def swiglu(x, w_gate, w_up, w_down):
    return (jax.nn.silu(x @ w_gate) * (x @ w_up)) @ w_down


def swa_mixer(x, w_in, sinks, w_out):
    B, S, _ = x.shape
    H, G, d, L = N_HEADS, SWA_KV_HEADS, HEAD_DIM, SWA_BLOCK
    R = H // G
    nb = S // L
    q, k, v = jnp.split(x @ w_in, [H * d, H * d + G * d], axis=-1)
    q = q.reshape(B, nb, L, G, R, d) * d ** -0.5
    k = k.reshape(B, nb, L, G, d)
    v = v.reshape(B, nb, L, G, d)
    prev = lambda t: jnp.concatenate([jnp.zeros_like(t[:, :1]), t[:, :-1]], axis=1)
    kb = jnp.concatenate([prev(k), k], axis=2)
    vb = jnp.concatenate([prev(v), v], axis=2)
    q_abs = jnp.arange(nb)[:, None] * L + jnp.arange(L)[None, :]
    k_abs = jnp.arange(nb)[:, None] * L - L + jnp.arange(2 * L)[None, :]
    dist = q_abs[:, :, None] - k_abs[:, None, :]
    valid = (dist >= 0) & (dist < SWA_WINDOW) & (k_abs[:, None, :] >= 0)
    slopes = alibi_slopes(H).reshape(1, G, R, 1, 1)
    s = jnp.einsum('bnqgrd,bnkgd->bngrqk', q, kb).astype(jnp.float32)
    s = s - slopes * dist[:, None, None].astype(jnp.float32)
    s = jnp.where(valid[:, None, None], s, NEG_INF)
    sink = sinks.astype(jnp.float32).reshape(1, 1, G, R, 1, 1)
    m = jnp.maximum(jnp.max(s, -1, keepdims=True), sink)
    e = jnp.exp(s - m)
    p = e / (jnp.sum(e, -1, keepdims=True) + jnp.exp(sink - m))
    o = jnp.einsum('bngrqk,bnkgd->bnqgrd', p.astype(v.dtype), vb)
    return o.reshape(B, S, H * d) @ w_out


def nsa_mixer(x, w_in, cmp_pos, cmp_w1, cmp_w2, w_out):
    B, S, _ = x.shape
    H, G, d = N_HEADS, NSA_KV_GROUPS, HEAD_DIM
    R = H // G
    L, STR, SL, W, QB = NSA_CMP_LEN, NSA_CMP_STRIDE, NSA_SEL_LEN, NSA_WINDOW, NSA_QBLOCK
    n_cmp = S // STR - 1
    n_sel = S // SL
    topk = min(NSA_TOPK, n_sel)
    f32 = jnp.float32
    splits = [H * d + i * G * d for i in range(7)]
    q, kc, vc, ks, vs, kw, vw, gl = jnp.split(x @ w_in, splits, axis=-1)
    q = q.reshape(B, S, G, R, d) * d ** -0.5
    kv = lambda t: t.reshape(B, S, G, d)
    slopes = alibi_slopes(H).reshape(G, R)
    t_pos = jnp.arange(S)

    def compress(t, pos, w1, w2):
        c = t.reshape(B, S // STR, STR, G, d)
        blocks = jnp.concatenate([c[:, :-1], c[:, 1:]], axis=2) + pos[:, None, :]
        return jax.nn.gelu(jnp.einsum('bnlgd,lde->bnge', blocks, w1)) @ w2

    k_cmp = compress(kv(kc), cmp_pos[0], cmp_w1[0], cmp_w2[0])
    v_cmp = compress(kv(vc), cmp_pos[1], cmp_w1[1], cmp_w2[1])
    blk = jnp.arange(n_cmp) * STR
    dist_c = (t_pos[:, None] - (blk[None, :] + (L - 1) / 2)).astype(f32)
    valid_c = (blk[None, :] + L - 1) <= t_pos[:, None]
    s_c = jnp.einsum('bsgrd,bngd->bgrsn', q, k_cmp).astype(f32) - slopes[:, :, None, None] * dist_c
    p_c = jnp.where(valid_c, jax.nn.softmax(jnp.where(valid_c, s_c, NEG_INF), axis=-1), 0.0)
    o_cmp = jnp.einsum('bgrsn,bngd->bsgrd', p_c.astype(x.dtype), v_cmp)

    sel_start = jnp.arange(n_sel) * SL
    overlap = ((blk[:, None] < sel_start[None, :] + SL) & (blk[:, None] + L > sel_start[None, :])).astype(f32)
    imp = jnp.einsum('bgrsn,nm->bgsm', p_c, overlap)
    cur = t_pos // SL
    j = jnp.arange(n_sel)
    causal_sel = j[None, :] <= cur[:, None]
    forced = (j[None, :] == 0) | (j[None, :] == cur[:, None]) | (j[None, :] == cur[:, None] - 1)
    score = jnp.where(causal_sel, imp + jnp.where(forced, NSA_FORCE_BONUS, 0.0), NEG_INF)
    top_score, sel_idx = lax.top_k(score, topk)
    sel_ok = top_score > 0.5 * NEG_INF

    ks_blocks = kv(ks).reshape(B, n_sel, SL, G, d).transpose(0, 3, 1, 2, 4)
    vs_blocks = kv(vs).reshape(B, n_sel, SL, G, d).transpose(0, 3, 1, 2, 4)
    kw_pad = jnp.pad(kv(kw), ((0, 0), (W, 0), (0, 0), (0, 0)))
    vw_pad = jnp.pad(kv(vw), ((0, 0), (W, 0), (0, 0), (0, 0)))
    b_ix = jnp.arange(B)[:, None, None, None]
    g_ix = jnp.arange(G)[None, :, None, None]

    def query_block(c):
        q0 = c * QB
        qc = lax.dynamic_slice_in_dim(q, q0, QB, axis=1)
        tq = q0 + jnp.arange(QB)
        idx = lax.dynamic_slice_in_dim(sel_idx, q0, QB, axis=2)
        ok = lax.dynamic_slice_in_dim(sel_ok, q0, QB, axis=2)
        k_sel = ks_blocks[b_ix, g_ix, idx]
        v_sel = vs_blocks[b_ix, g_ix, idx]
        kpos = idx[..., None] * SL + jnp.arange(SL)
        dsel = tq[None, None, :, None, None] - kpos
        msel = ok[..., None] & (dsel >= 0)
        s = jnp.einsum('bqgrd,bgqkld->bgrqkl', qc, k_sel).astype(f32)
        s = s - slopes[None, :, :, None, None, None] * dsel[:, :, None].astype(f32)
        s = jnp.where(msel[:, :, None], s, NEG_INF).reshape(B, G, R, QB, topk * SL)
        p = jax.nn.softmax(s, axis=-1).reshape(B, G, R, QB, topk, SL).astype(x.dtype)
        o_sel = jnp.einsum('bgrqkl,bgqkld->bqgrd', p, v_sel)
        kwin = lax.dynamic_slice_in_dim(kw_pad, q0, W + QB, axis=1)
        vwin = lax.dynamic_slice_in_dim(vw_pad, q0, W + QB, axis=1)
        wpos = q0 - W + jnp.arange(W + QB)
        dw = tq[:, None] - wpos[None, :]
        mw = (dw >= 0) & (dw < W) & (wpos[None, :] >= 0)
        sw = jnp.einsum('bqgrd,bkgd->bgrqk', qc, kwin).astype(f32) - slopes[:, :, None, None] * dw.astype(f32)
        pw = jax.nn.softmax(jnp.where(mw, sw, NEG_INF), axis=-1).astype(x.dtype)
        o_win = jnp.einsum('bgrqk,bkgd->bqgrd', pw, vwin)
        return o_sel, o_win

    o_sel, o_win = lax.map(query_block, jnp.arange(S // QB))
    o_sel = jnp.moveaxis(o_sel, 0, 1).reshape(B, S, G, R, d)
    o_win = jnp.moveaxis(o_win, 0, 1).reshape(B, S, G, R, d)
    g = jax.nn.sigmoid(gl.astype(f32)).reshape(B, S, 3, G, R)[..., None]
    o = g[:, :, 0] * o_cmp + g[:, :, 1] * o_sel + g[:, :, 2] * o_win
    return o.astype(x.dtype).reshape(B, S, H * d) @ w_out


def gla_mixer(x, w_in, w_gate2, b_gate, norm_g, w_out):
    B, S, _ = x.shape
    H, C = GLA_HEADS, GLA_CHUNK
    dk, dv = GLA_DK // H, GLA_DV // H
    nc = S // C
    f32 = jnp.float32
    q, k, v, g_lr, r = jnp.split(
        x @ w_in, [GLA_DK, 2 * GLA_DK, 2 * GLA_DK + GLA_DV, 2 * GLA_DK + GLA_DV + GLA_GATE_RANK], axis=-1)
    log_a = jax.nn.log_sigmoid((g_lr @ w_gate2 + b_gate).astype(f32)) / GLA_TAU

    def chunks(t, hd):
        return t.astype(f32).reshape(B, nc, C, H, hd).transpose(1, 0, 3, 2, 4)

    qc = chunks(q, dk) * dk ** -0.5
    kc = chunks(k, dk)
    vc = chunks(v, dv)
    bc = jnp.cumsum(chunks(log_a, dk), axis=3)
    causal = jnp.tril(jnp.ones((C, C), dtype=bool))

    def step(state, inp):
        q_, k_, v_, b_ = inp
        decay = jnp.exp(jnp.where(causal[:, :, None], b_[:, :, :, None, :] - b_[:, :, None, :, :], NEG_INF))
        att = jnp.einsum('bhik,bhjk,bhijk->bhij', q_, k_, decay)
        out = jnp.einsum('bhij,bhjv->bhiv', att, v_) + jnp.einsum('bhik,bhkv->bhiv', q_ * jnp.exp(b_), state)
        b_last = b_[:, :, -1, :]
        state = jnp.exp(b_last)[..., None] * state + jnp.einsum(
            'bhjk,bhjv->bhkv', k_ * jnp.exp(b_last[:, :, None, :] - b_), v_)
        return state, out

    state0 = jnp.zeros((B, H, dk, dv), f32)
    _, o = lax.scan(step, state0, (qc, kc, vc, bc))
    o = o.transpose(1, 0, 3, 2, 4).reshape(B, S, H, dv)
    o = o * lax.rsqrt(jnp.mean(jnp.square(o), -1, keepdims=True) + LN_EPS) * norm_g
    o = o.reshape(B, S, GLA_DV) * jax.nn.silu(r.astype(f32))
    return o.astype(x.dtype) @ w_out


def pool_mixer(x, w_grp, scale):
    B, S, D = x.shape
    ng = len(POOL_WINDOWS)
    xg = x.astype(jnp.float32).reshape(B, S, ng, POOL_GROUP)
    csum = jnp.pad(jnp.cumsum(xg, axis=1), ((0, 0), (1, 0), (0, 0), (0, 0)))
    t = jnp.arange(S)
    pooled = []
    for gi, w in enumerate(POOL_WINDOWS):
        lo = jnp.maximum(t + 1 - w, 0)
        cg = csum[:, :, gi]
        total = cg[:, 1:] - cg[:, lo]
        pooled.append(total / (t + 1 - lo).astype(jnp.float32)[:, None])
    pooled = jnp.stack(pooled, axis=2)
    y = jnp.einsum('bsgc,gce->bsge', pooled - xg, w_grp.astype(jnp.float32)).reshape(B, S, D) * scale
    return y.astype(x.dtype)


def mem_cross_attention(x, mem, w_q, w_kv, w_o):
    B, S, D = x.shape
    M = mem.shape[1]
    Hx = XATTN_HEADS
    dh = D // Hx
    q = (x @ w_q).reshape(B, S, Hx, dh) * dh ** -0.5
    k, v = jnp.split(mem @ w_kv, 2, axis=-1)
    k = k.reshape(B, M, Hx, dh)
    v = v.reshape(B, M, Hx, dh)
    s = jnp.einsum('bshd,bmhd->bhsm', q, k).astype(jnp.float32)
    p = jax.nn.softmax(s, axis=-1).astype(v.dtype)
    o = jnp.einsum('bhsm,bmhd->bshd', p, v).reshape(B, S, D)
    return o @ w_o


def setup_inputs(seed: int = 0) -> dict:
    key = jax.random.key(seed)
    keys = jax.random.split(key, 28)
    D, F, d, H = D_MODEL, FFN_DIM, HEAD_DIM, N_HEADS
    nA, nB, nC, nD = [len(range(k, DEPTH, N_MIXERS)) for k in range(N_MIXERS)]
    L = NSA_CMP_LEN

    def nrm(i, shape, scale):
        return scale * jax.random.normal(keys[i], shape, jnp.float32)

    return {
        'x': nrm(0, (BATCH, SEQ, D), 1.0),
        'mem': nrm(1, (BATCH, MEM_LEN, D), 1.0),
        'ln_g': jnp.ones((DEPTH, 4, D), jnp.float32) + nrm(2, (DEPTH, 4, D), 0.02),
        'ln_b': nrm(3, (DEPTH, 4, D), 0.02),
        'ffn1_w_gate': nrm(4, (DEPTH, D, F), D ** -0.5),
        'ffn1_w_up': nrm(5, (DEPTH, D, F), D ** -0.5),
        'ffn1_w_down': nrm(6, (DEPTH, F, D), DN_BETA * F ** -0.5),
        'ffn2_w_gate': nrm(7, (DEPTH, D, F), D ** -0.5),
        'ffn2_w_up': nrm(8, (DEPTH, D, F), D ** -0.5),
        'ffn2_w_down': nrm(9, (DEPTH, F, D), DN_BETA * F ** -0.5),
        'xattn_w_q': nrm(10, (DEPTH, D, D), D ** -0.5),
        'xattn_w_kv': nrm(11, (DEPTH, D, 2 * D), D ** -0.5),
        'xattn_w_o': nrm(12, (DEPTH, D, D), DN_BETA * D ** -0.5),
        'swa_w_in': nrm(13, (nA, D, SWA_IN), D ** -0.5),
        'swa_sinks': nrm(14, (nA, H), 1.0),
        'swa_w_out': nrm(15, (nA, H * d, D), DN_BETA * D ** -0.5),
        'nsa_w_in': nrm(16, (nB, D, NSA_IN), D ** -0.5),
        'nsa_cmp_pos': nrm(17, (nB, 2, L, d), 0.1),
        'nsa_cmp_w1': nrm(18, (nB, 2, L, d, d), (L * d) ** -0.5),
        'nsa_cmp_w2': nrm(19, (nB, 2, d, d), d ** -0.5),
        'nsa_w_out': nrm(20, (nB, H * d, D), DN_BETA * D ** -0.5),
        'gla_w_in': nrm(21, (nC, D, GLA_IN), D ** -0.5),
        'gla_w_gate2': nrm(22, (nC, GLA_GATE_RANK, GLA_DK), GLA_GATE_RANK ** -0.5),
        'gla_b_gate': nrm(23, (nC, GLA_DK), 0.1),
        'gla_norm_g': jnp.ones((nC, GLA_DV // GLA_HEADS), jnp.float32) + nrm(24, (nC, GLA_DV // GLA_HEADS), 0.02),
        'gla_w_out': nrm(25, (nC, GLA_DV, D), DN_BETA * GLA_DV ** -0.5),
        'pool_w': nrm(26, (nD, len(POOL_WINDOWS), POOL_GROUP, POOL_GROUP), DN_BETA * POOL_GROUP ** -0.5),
        'pool_scale': jnp.ones((nD, D), jnp.float32) + nrm(27, (nD, D), 0.02),
    }


def reference(x, mem, ln_g, ln_b,
              ffn1_w_gate, ffn1_w_up, ffn1_w_down, ffn2_w_gate, ffn2_w_up, ffn2_w_down,
              xattn_w_q, xattn_w_kv, xattn_w_o,
              swa_w_in, swa_sinks, swa_w_out,
              nsa_w_in, nsa_cmp_pos, nsa_cmp_w1, nsa_cmp_w2, nsa_w_out,
              gla_w_in, gla_w_gate2, gla_b_gate, gla_norm_g, gla_w_out,
              pool_w, pool_scale):
    for i in range(DEPTH):
        kind = i % N_MIXERS
        j = i // N_MIXERS
        x = layer_norm(DN_ALPHA * x + 0.5 * swiglu(x, ffn1_w_gate[i], ffn1_w_up[i], ffn1_w_down[i]),
                       ln_g[i, 0], ln_b[i, 0])
        if kind == 0:
            y = swa_mixer(x, swa_w_in[j], swa_sinks[j], swa_w_out[j])
        elif kind == 1:
            y = nsa_mixer(x, nsa_w_in[j], nsa_cmp_pos[j], nsa_cmp_w1[j], nsa_cmp_w2[j], nsa_w_out[j])
        elif kind == 2:
            y = gla_mixer(x, gla_w_in[j], gla_w_gate2[j], gla_b_gate[j], gla_norm_g[j], gla_w_out[j])
        else:
            y = pool_mixer(x, pool_w[j], pool_scale[j])
        x = layer_norm(DN_ALPHA * x + y, ln_g[i, 1], ln_b[i, 1])
        x = layer_norm(DN_ALPHA * x + mem_cross_attention(x, mem, xattn_w_q[i], xattn_w_kv[i], xattn_w_o[i]),
                       ln_g[i, 2], ln_b[i, 2])
        x = layer_norm(DN_ALPHA * x + 0.5 * swiglu(x, ffn2_w_gate[i], ffn2_w_up[i], ffn2_w_down[i]),
                       ln_g[i, 3], ln_b[i, 3])
    return x
```

```cpp
#include <hip/hip_runtime.h>
#include <hip/hip_cooperative_groups.h>
#include <cstdio>
namespace cg = cooperative_groups;

typedef unsigned short u16;
typedef unsigned int u32;
using bf16x8 = __attribute__((ext_vector_type(8))) short;
using f32x4 = __attribute__((ext_vector_type(4))) float;
typedef float f32x2_t __attribute__((ext_vector_type(2)));
typedef __bf16 bf16x2_t __attribute__((ext_vector_type(2)));
#define DEV __device__ __forceinline__
#define MFMA16(a, b, c) __builtin_amdgcn_mfma_f32_16x16x32_bf16((a), (b), (c), 0, 0, 0)

constexpr int MTOK = 32768;
constexpr int SEQL = 2048;
constexpr int FF = 2816;
constexpr float ALPHA = 1.6817928305074290f;
constexpr float NEGBIG = -1e30f;
constexpr float LOG2E = 1.4426950408889634f;
constexpr int NTHREADS = 256;
constexpr int SMEM_BYTES = 80896;

constexpr size_t MiB = 1ull << 20;
constexpr size_t OFF_XB = 0;
constexpr size_t OFF_BIG = 64 * MiB;
constexpr size_t OFF_AO = 272 * MiB;
constexpr size_t OFF_WT = 336 * MiB;
constexpr size_t OFF_MEMB = 388 * MiB;
constexpr size_t OFF_KB = 396 * MiB;
constexpr size_t OFF_VT = 404 * MiB;
constexpr size_t OFF_ATT = 412 * MiB;
constexpr size_t OFF_CMP = 444 * MiB;
constexpr size_t OFF_SEL = 448 * MiB;
constexpr size_t OFF_GD = 449 * MiB;
constexpr size_t OFF_BAR = 451 * MiB;
constexpr size_t OFF_LNX = 484 * MiB;
constexpr size_t OFF_LNF = OFF_BAR + 16384;
constexpr size_t OFF_KT = 452 * MiB;
constexpr size_t BIG_GVT = 144 * MiB;
constexpr size_t BIG_VT2 = 112 * MiB;
constexpr size_t BIG_OC = 128 * MiB;
constexpr size_t W_GU1 = 0;
constexpr size_t W_D1 = W_GU1 + 5632ull * 1024;
constexpr size_t W_GU2 = W_D1 + 1024ull * 2816;
constexpr size_t W_D2 = W_GU2 + 5632ull * 1024;
constexpr size_t W_XQ = W_D2 + 1024ull * 2816;
constexpr size_t W_XKV = W_XQ + 1024ull * 1024;
constexpr size_t W_XO = W_XKV + 2048ull * 1024;
constexpr size_t W_MIN = W_XO + 1024ull * 1024;
constexpr size_t W_MOUT = W_MIN + 3328ull * 1024;

struct Params {
  const float* in[28];
  float* xf;
  char* ws;
};

DEV int otid() { int t = threadIdx.x; asm volatile("" : "+v"(t)); return t; }
DEV size_t kb32(size_t row, int col, size_t R) { return ((size_t)(col >> 5) * R + row) * 32 + (col & 31); }
DEV float bf2f(u16 h) { return __uint_as_float(((u32)h) << 16); }
DEV u32 pk2(float a, float b) {
  f32x2_t v = {a, b};
  bf16x2_t r = __builtin_convertvector(v, bf16x2_t);
  return __builtin_bit_cast(u32, r);
}
DEV u16 f2bf(float a) { return (u16)(pk2(a, 0.f) & 0xffffu); }
DEV float bflo(u32 w) { return __uint_as_float(w << 16); }
DEV float bfhi(u32 w) { return __uint_as_float(w & 0xffff0000u); }


#define XB_TMO      128
#define XB_XCNT(j)  (256  + 64 * (j))
#define XB_XSUB(j)  (1280 + 64 * (j))
#define XB_XGEN(j)  (2304 + 64 * (j))
#define XB_TOP      3328
#define XB_TOPGEN   3392
#define XCD_BAR_WORDS 3456
#define XB_SPIN_CAP (1u << 22)
#define LAS __attribute__((address_space(3)))
DEV unsigned xb_ld(unsigned* p) { return __hip_atomic_load(p, __ATOMIC_RELAXED, __HIP_MEMORY_SCOPE_AGENT); }
DEV unsigned xb_add(unsigned* p, unsigned v) { return __hip_atomic_fetch_add(p, v, __ATOMIC_RELAXED, __HIP_MEMORY_SCOPE_AGENT); }
DEV unsigned xb_xcc_id() { return (unsigned)__builtin_amdgcn_s_getreg((3 << 11) | 20) & 0xFu; }
#define XB_SPIN(cond, bar) do { unsigned _sp = 0; while (cond) { __builtin_amdgcn_s_sleep(1); \
    if ((++_sp & 255u) == 0u) { if (xb_ld(&(bar)[XB_TMO])) break; if (_sp > XB_SPIN_CAP) { atomicAdd(&(bar)[XB_TMO], 1u); break; } } } } while (0)
struct XcdBarrier { unsigned* bar; unsigned x; volatile unsigned* st; };
DEV XcdBarrier xcd_barrier_post(unsigned* bar, volatile unsigned* st) {
  XcdBarrier b; b.bar = bar; b.x = xb_xcc_id(); b.st = st;
  if (threadIdx.x == 0) (void)xb_add(&bar[XB_XCNT(b.x)], 1u);
  return b;
}
DEV void xcd_barrier_complete(unsigned* bar, unsigned x, unsigned& nloc, unsigned& nx) {
  const unsigned G = gridDim.x * gridDim.y * gridDim.z;
  unsigned sum, cnt, mine, sp = 0u;
  for (;;) {
    sum = 0u; cnt = 0u; mine = 0u;
#pragma unroll
    for (unsigned j = 0; j < 16; ++j) { const unsigned c = xb_ld(&bar[XB_XCNT(j)]); sum += c; cnt += (c > 0u) ? 1u : 0u; mine = (j == x) ? c : mine; }
    if (sum == G) break;
    __builtin_amdgcn_s_sleep(1);
    if ((++sp & 255u) == 0u) { if (xb_ld(&bar[XB_TMO])) break; if (sp > XB_SPIN_CAP) { atomicAdd(&bar[XB_TMO], 1u); break; } }
  }
  nloc = mine > 0u ? mine : 1u; nx = cnt > 0u ? cnt : 1u;
}
DEV void xcd_barrier(const XcdBarrier& b) {
  asm volatile("s_waitcnt vmcnt(0)" ::: "memory");
  __syncthreads();
  if (threadIdx.x == 0) {
    unsigned* bar = b.bar;
    __builtin_amdgcn_s_waitcnt(0);
    unsigned nloc = b.st[0], nx = b.st[1];
    if (nloc == 0u) { xcd_barrier_complete(bar, b.x, nloc, nx); b.st[0] = nloc; b.st[1] = nx; }
    const unsigned old = xb_add(&bar[XB_XSUB(b.x)], 1u);
    const unsigned gen = old / nloc;
    if (old + 1u == (gen + 1u) * nloc) {
      __builtin_amdgcn_fence(__ATOMIC_RELEASE, "agent");
      asm volatile("s_waitcnt vmcnt(0)" ::: "memory");
      const unsigned og = xb_add(&bar[XB_TOP], 1u);
      const unsigned tg = og / nx;
      if (og + 1u == (tg + 1u) * nx) xb_add(&bar[XB_TOPGEN], 1u);
      else XB_SPIN(xb_ld(&bar[XB_TOPGEN]) == tg, bar);
      __builtin_amdgcn_fence(__ATOMIC_ACQUIRE, "agent");
      xb_add(&bar[XB_XGEN(b.x)], 1u);
      asm volatile("s_waitcnt vmcnt(0)" ::: "memory");
    } else {
      XB_SPIN(xb_ld(&bar[XB_XGEN(b.x)]) == gen, bar);
      __builtin_amdgcn_fence(__ATOMIC_ACQUIRE, "agent");
      asm volatile("s_waitcnt vmcnt(0)" ::: "memory");
    }
  }
  __syncthreads();
}

DEV void phase_init(const Params& p) {
  const float4* x4 = (const float4*)p.in[0];
  uint2* xb2 = (uint2*)(p.ws + OFF_XB);
  const size_t n4 = (size_t)MTOK * 1024 / 4;
  for (size_t i = (size_t)blockIdx.x * NTHREADS + otid(); i < n4; i += (size_t)gridDim.x * NTHREADS) {
    float4 v = x4[i];
    *(uint2*)((u16*)xb2 + kb32(i >> 8, (int)(i & 255) * 4, MTOK)) = make_uint2(pk2(v.x, v.y), pk2(v.z, v.w));
  }
  const float4* m4 = (const float4*)p.in[1];
  uint2* mb2 = (uint2*)(p.ws + OFF_MEMB);
  const size_t nm4 = (size_t)4096 * 1024 / 4;
  for (size_t i = (size_t)blockIdx.x * NTHREADS + otid(); i < nm4; i += (size_t)gridDim.x * NTHREADS) {
    float4 v = m4[i];
    *(uint2*)((u16*)mb2 + kb32(i >> 8, (int)(i & 255) * 4, 4096)) = make_uint2(pk2(v.x, v.y), pk2(v.z, v.w));
  }
}

DEV void conv_job(int& base, const float* src, const float* src2, int mode, int lds, int s0, int cnt, int cntpad,
                  int K, u16* dst, int d0, float scale, char* smem, int Rtot, const float* rowscale = nullptr) {
  float* t = (float*)smem;
  const int nrt = cntpad >> 6, nkt = K >> 6, nt = nrt * nkt;
  const int G = gridDim.x;
  int first = ((int)blockIdx.x - (base % G) + G) % G;
  const int tid = otid();
  for (int tile = first; tile < nt; tile += G) {
    const int r0 = (tile % nrt) << 6, k0 = (tile / nrt) << 6;
#pragma unroll 4
    for (int i = 0; i < 16; ++i) {
      int idx = tid + 256 * i;
      int kk = idx >> 6, r = idx & 63;
      int n = r0 + r;
      float v = 0.f;
      if (n < cnt) {
        const float* sp = src;
        int col = s0 + n;
        if (mode) { sp = ((n >> 4) & 1) ? src2 : src; col = ((n >> 5) << 4) + (n & 15); }
        v = sp[(size_t)(k0 + kk) * lds + col] * scale;
        if (rowscale) v *= rowscale[n];
      }
      t[kk * 65 + r] = v;
    }
    __syncthreads();
    {
      int r = tid >> 2, kc = (tid & 3) << 4;
      u32 w[8];
#pragma unroll
      for (int j = 0; j < 8; ++j) w[j] = pk2(t[(kc + 2 * j) * 65 + r], t[(kc + 2 * j + 1) * 65 + r]);
      uint4* dp = (uint4*)(dst + kb32(d0 + r0 + r, k0 + kc, Rtot));
      dp[0] = make_uint4(w[0], w[1], w[2], w[3]);
      dp[1] = make_uint4(w[4], w[5], w[6], w[7]);
    }
    __syncthreads();
  }
  base += nt;
}

DEV void phase_conv_weights(const Params& p, int L, char* smem) {
  u16* wt = (u16*)(p.ws + OFF_WT);
  int base = 0;
  const size_t fo = (size_t)L * 1024 * FF;
  conv_job(base, p.in[4] + fo, p.in[5] + fo, 1, FF, 0, 5632, 5632, 1024, wt + W_GU1, 0, 1.f, smem, 5632);
  conv_job(base, p.in[6] + fo, nullptr, 0, 1024, 0, 1024, 1024, FF, wt + W_D1, 0, 1.f, smem, 1024);
  conv_job(base, p.in[7] + fo, p.in[8] + fo, 1, FF, 0, 5632, 5632, 1024, wt + W_GU2, 0, 1.f, smem, 5632);
  conv_job(base, p.in[9] + fo, nullptr, 0, 1024, 0, 1024, 1024, FF, wt + W_D2, 0, 1.f, smem, 1024);
  conv_job(base, p.in[10] + (size_t)L * 1024 * 1024, nullptr, 0, 1024, 0, 1024, 1024, 1024, wt + W_XQ, 0, 0.0625f * LOG2E, smem, 1024);
  conv_job(base, p.in[11] + (size_t)L * 1024 * 2048, nullptr, 0, 2048, 0, 2048, 2048, 1024, wt + W_XKV, 0, 1.f, smem, 2048);
  conv_job(base, p.in[12] + (size_t)L * 1024 * 1024, nullptr, 0, 1024, 0, 1024, 1024, 1024, wt + W_XO, 0, 1.f, smem, 1024);
  if (L == 0) {
    conv_job(base, p.in[13], nullptr, 0, 1536, 0, 1024, 1024, 1024, wt + W_MIN, 0, 0.125f * LOG2E, smem, 1536);
    conv_job(base, p.in[13], nullptr, 0, 1536, 1024, 512, 512, 1024, wt + W_MIN, 1024, 1.f, smem, 1536);
    conv_job(base, p.in[15], nullptr, 0, 1024, 0, 1024, 1024, 1024, wt + W_MOUT, 0, 1.f, smem, 1024);
  } else if (L == 1) {
    conv_job(base, p.in[16], nullptr, 0, 1840, 0, 1024, 1024, 1024, wt + W_MIN, 0, 0.125f * LOG2E, smem, 2048);
    conv_job(base, p.in[16], nullptr, 0, 1840, 1024, 384, 384, 1024, wt + W_MIN, 1024, 1.f, smem, 2048);
    conv_job(base, p.in[16], nullptr, 0, 1840, 1536, 128, 128, 1024, wt + W_MIN, 1408, 1.f, smem, 2048);
    conv_job(base, p.in[16], nullptr, 0, 1840, 1792, 48, 256, 1024, wt + W_MIN, 1536, 1.f, smem, 2048);
    conv_job(base, p.in[16], nullptr, 0, 1840, 1408, 128, 128, 1024, wt + W_MIN, 1792, 1.f, smem, 2048);
    conv_job(base, p.in[16], nullptr, 0, 1840, 1664, 128, 128, 1024, wt + W_MIN, 1920, 1.f, smem, 2048);
    conv_job(base, p.in[20], nullptr, 0, 1024, 0, 1024, 1024, 1024, wt + W_MOUT, 0, 1.f, smem, 1024);
  } else if (L == 2) {
    conv_job(base, p.in[21], nullptr, 0, 3088, 0, 1024, 1024, 1024, wt + W_MIN, 0, 1.f, smem, 3328);
    conv_job(base, p.in[21], nullptr, 0, 3088, 2048, 1040, 1280, 1024, wt + W_MIN, 1024, 1.f, smem, 3328);
    conv_job(base, p.in[21], nullptr, 0, 3088, 1024, 1024, 1024, 1024, wt + W_MIN, 2304, 1.f, smem, 3328);
    conv_job(base, p.in[25], nullptr, 0, 1024, 0, 1024, 1024, 1024, wt + W_MOUT, 0, 1.f, smem, 1024);
  } else {
    for (int g = 0; g < 4; ++g)
      conv_job(base, p.in[26] + (size_t)g * 65536, nullptr, 0, 256, 0, 256, 256, 256, wt + W_MIN, g * 256, 1.f, smem, 1024, p.in[27] + g * 256);
  }
}

constexpr int G2_STAGE = 384 * 64;
typedef int i32x4_t __attribute__((ext_vector_type(4)));
DEV i32x4_t make_srd(const void* p) {
  const unsigned long long a = (unsigned long long)p;
  i32x4_t r;
  r[0] = (int)(unsigned)(a & 0xffffffffull);
  r[1] = (int)(unsigned)((a >> 32) & 0xffffull);
  r[2] = -1;
  r[3] = 0x00020000;
  return r;
}
DEV void dma16(const i32x4_t& srd, unsigned voff, unsigned soff, unsigned m0v) {
  asm volatile("s_mov_b32 m0, %0\n\ts_nop 0\n\tbuffer_load_dwordx4 %1, %2, %3 offen lds"
               :: "s"(m0v), "v"(voff), "s"(srd), "s"(soff) : "m0", "memory");
}

DEV void gemm_mainloop(const u16* __restrict__ P, int ldp, const u16* __restrict__ Q, int ldq, int K, char* smem,
                       f32x4 (&acc)[8][4], const u16* __restrict__ Pn, const u16* __restrict__ Qn, int& st) {
  const int tid = otid(), lane = tid & 63, wave = tid >> 6;
  const int wp = wave >> 1, wq = wave & 1, l15 = lane & 15, q4 = lane >> 4;
#pragma unroll
  for (int a = 0; a < 8; ++a)
#pragma unroll
    for (int b = 0; b < 4; ++b) acc[a][b] = f32x4{0.f, 0.f, 0.f, 0.f};
  const int lr = tid >> 2, lc = ((tid & 3) ^ ((0x78 >> (2 * ((tid >> 4) & 3))) & 3)) * 8;
  const unsigned loff = (unsigned)(lr * 32 + lc) * 2u;
  const unsigned kstP = (unsigned)ldp * 64u, kstQ = (unsigned)ldq * 64u;
  const i32x4_t srdP = make_srd(P), srdQ = make_srd(Q);
  const i32x4_t srdPn = make_srd(Pn ? Pn : P), srdQn = make_srd(Qn ? Qn : Q);
  const bool has_next = (Pn != nullptr);
  const unsigned lds0 = (unsigned)__builtin_amdgcn_readfirstlane((int)((unsigned)(size_t)(__attribute__((address_space(3))) char*)smem + (unsigned)wave * 1024u));
  const int nk = K >> 5;
  const int swz = (q4 ^ ((0x78 >> (2 * ((l15 >> 2) & 3))) & 3)) * 16;
  const int prd = (wp * 128 + l15) * 64 + swz;
  const int qrd = (256 + wq * 64 + l15) * 64 + swz;
  for (int kt = 0; kt < nk; ++kt) {
    if (kt + 1 < nk || has_next) asm volatile("s_waitcnt vmcnt(6)" ::: "memory");
    else asm volatile("s_waitcnt vmcnt(0)" ::: "memory");
    __builtin_amdgcn_s_barrier();
    asm volatile("" ::: "memory");
    {
      const int st2 = (st >= 1) ? st - 1 : 2;
      const unsigned sd_ = lds0 + (unsigned)st2 * G2_STAGE;
      if (kt + 2 < nk) {
        const unsigned gp_ = (unsigned)(kt + 2) * kstP, gq_ = (unsigned)(kt + 2) * kstQ;
#pragma unroll
        for (int i_ = 0; i_ < 4; ++i_) dma16(srdP, loff, gp_ + i_ * 4096, sd_ + i_ * 4096);
#pragma unroll
        for (int i_ = 0; i_ < 2; ++i_) dma16(srdQ, loff, gq_ + i_ * 4096, sd_ + (4 + i_) * 4096);
      } else if (has_next) {
        const unsigned gp_ = (unsigned)(kt + 2 - nk) * kstP, gq_ = (unsigned)(kt + 2 - nk) * kstQ;
#pragma unroll
        for (int i_ = 0; i_ < 4; ++i_) dma16(srdPn, loff, gp_ + i_ * 4096, sd_ + i_ * 4096);
#pragma unroll
        for (int i_ = 0; i_ < 2; ++i_) dma16(srdQn, loff, gq_ + i_ * 4096, sd_ + (4 + i_) * 4096);
      }
    }
    const char* sb = smem + st * G2_STAGE;
    bf16x8 pf[8], qf[4];
#pragma unroll
    for (int b = 0; b < 4; ++b) qf[b] = *(const bf16x8*)(sb + qrd + b * 1024);
#pragma unroll
    for (int a = 0; a < 8; ++a) pf[a] = *(const bf16x8*)(sb + prd + a * 1024);
    __builtin_amdgcn_s_setprio(1);
#pragma unroll
    for (int a = 0; a < 8; ++a)
#pragma unroll
      for (int b = 0; b < 4; ++b) acc[a][b] = MFMA16(pf[a], qf[b], acc[a][b]);
    __builtin_amdgcn_s_setprio(0);
    st = (st == 2) ? 0 : st + 1;
  }
}

DEV void gemm_prime(const u16* __restrict__ P, int ldp, const u16* __restrict__ Q, int ldq, int K, char* smem) {
  const int tid = otid(), wave = tid >> 6;
  const int lr = tid >> 2, lc = ((tid & 3) ^ ((0x78 >> (2 * ((tid >> 4) & 3))) & 3)) * 8;
  const unsigned loff = (unsigned)(lr * 32 + lc) * 2u;
  const unsigned kstP = (unsigned)ldp * 64u, kstQ = (unsigned)ldq * 64u;
  const i32x4_t srdP = make_srd(P), srdQ = make_srd(Q);
  const unsigned lds0 = (unsigned)__builtin_amdgcn_readfirstlane((int)((unsigned)(size_t)(__attribute__((address_space(3))) char*)smem + (unsigned)wave * 1024u));
#pragma unroll
  for (int kt = 0; kt < 2; ++kt) {
    const unsigned sd_ = lds0 + (unsigned)kt * G2_STAGE;
#pragma unroll
    for (int i_ = 0; i_ < 4; ++i_) dma16(srdP, loff, kt * kstP + i_ * 4096, sd_ + i_ * 4096);
#pragma unroll
    for (int i_ = 0; i_ < 2; ++i_) dma16(srdQ, loff, kt * kstQ + i_ * 4096, sd_ + (4 + i_) * 4096);
  }
}

struct EpiArgs {
  void* out;
  int ldo;
  float s;
  const float* colscale;
  const float* xin;
  float* xf;
  u16* xb;
  const float* lng;
  const float* lnb;
  unsigned long long* slots;
  unsigned* flags;
};

template <int EPI>
DEV void gemm_epilogue(f32x4 (&acc)[8][4], int p0, int q0, const EpiArgs& ea, char* smem) {
  const int tid = otid(), lane = tid & 63, wave = tid >> 6;
  const int wp = wave >> 1, wq = wave & 1, l15 = lane & 15, q4 = lane >> 4;
  if (EPI == 4) {
    float* red = (float*)(smem + 3 * G2_STAGE);
    float* stat = red + 512;
    const int pi = p0 >> 8, qi = q0 >> 7;
    float rs[4], rq[4];
#pragma unroll
    for (int b = 0; b < 4; ++b) {
      rs[b] = 0.f; rq[b] = 0.f;
      const size_t q = q0 + wq * 64 + b * 16 + l15;
#pragma unroll
      for (int a = 0; a < 8; ++a) {
        const int pp = p0 + wp * 128 + a * 16 + q4 * 4;
        const float4 x = *(const float4*)(ea.xin + q * 1024 + pp);
        f32x4 y;
        y[0] = ALPHA * x.x + ea.s * acc[a][b][0];
        y[1] = ALPHA * x.y + ea.s * acc[a][b][1];
        y[2] = ALPHA * x.z + ea.s * acc[a][b][2];
        y[3] = ALPHA * x.w + ea.s * acc[a][b][3];
        acc[a][b] = y;
        rs[b] += (y[0] + y[1]) + (y[2] + y[3]);
        rq[b] += (y[0] * y[0] + y[1] * y[1]) + (y[2] * y[2] + y[3] * y[3]);
        if (a == 7) __builtin_amdgcn_sched_barrier(0);
      }
      rs[b] += __shfl_xor(rs[b], 16); rs[b] += __shfl_xor(rs[b], 32);
      rq[b] += __shfl_xor(rq[b], 16); rq[b] += __shfl_xor(rq[b], 32);
      if (q4 == 0) {
        red[(wp * 128 + wq * 64 + b * 16 + l15) * 2] = rs[b];
        red[(wp * 128 + wq * 64 + b * 16 + l15) * 2 + 1] = rq[b];
      }
    }
    __syncthreads();
    unsigned long long* slot = ea.slots + ((size_t)qi * 4) * 128;
    if (tid < 128) {
      const float S = red[tid * 2] + red[(128 + tid) * 2];
      const float Q = red[tid * 2 + 1] + red[(128 + tid) * 2 + 1];
      const unsigned long long v = ((unsigned long long)__float_as_uint(Q) << 32) | (unsigned long long)__float_as_uint(S);
      __hip_atomic_store(slot + (size_t)pi * 128 + tid, v, __ATOMIC_RELAXED, __HIP_MEMORY_SCOPE_AGENT);
    }
    asm volatile("s_waitcnt vmcnt(0)" ::: "memory");
    __syncthreads();
    if (tid == 0) {
      __hip_atomic_fetch_add(ea.flags + qi, 1u, __ATOMIC_RELAXED, __HIP_MEMORY_SCOPE_AGENT);
      unsigned sp = 0;
      while (__hip_atomic_load(ea.flags + qi, __ATOMIC_RELAXED, __HIP_MEMORY_SCOPE_AGENT) < 4u) {
        __builtin_amdgcn_s_sleep(1);
        if (++sp > (1u << 22)) break;
      }
    }
    __syncthreads();
    if (tid < 128) {
      float S = 0.f, Q = 0.f;
#pragma unroll
      for (int pj = 0; pj < 4; ++pj) {
        const unsigned long long v = __hip_atomic_load(slot + (size_t)pj * 128 + tid, __ATOMIC_RELAXED, __HIP_MEMORY_SCOPE_AGENT);
        S += __uint_as_float((unsigned)(v & 0xffffffffull));
        Q += __uint_as_float((unsigned)(v >> 32));
      }
      const float mu = S * (1.f / 1024.f);
      const float var = fmaxf(Q * (1.f / 1024.f) - mu * mu, 0.f);
      stat[tid * 2] = mu;
      stat[tid * 2 + 1] = rsqrtf(var + 1e-5f);
    }
    __syncthreads();
    float mu4[4], rs4[4];
#pragma unroll
    for (int b = 0; b < 4; ++b) { const int r = wq * 64 + b * 16 + l15; mu4[b] = stat[r * 2]; rs4[b] = stat[r * 2 + 1]; }
#pragma unroll
    for (int a = 0; a < 8; ++a) {
      const int pp = p0 + wp * 128 + a * 16 + q4 * 4;
      const float4 gg = *(const float4*)(ea.lng + pp), bb = *(const float4*)(ea.lnb + pp);
#pragma unroll
      for (int b = 0; b < 4; ++b) {
        const size_t q = q0 + wq * 64 + b * 16 + l15;
        float4 y;
        y.x = (acc[a][b][0] - mu4[b]) * rs4[b] * gg.x + bb.x;
        y.y = (acc[a][b][1] - mu4[b]) * rs4[b] * gg.y + bb.y;
        y.z = (acc[a][b][2] - mu4[b]) * rs4[b] * gg.z + bb.z;
        y.w = (acc[a][b][3] - mu4[b]) * rs4[b] * gg.w + bb.w;
        *(float4*)(ea.xf + q * 1024 + pp) = y;
        if (ea.xb) *(uint2*)(ea.xb + kb32(q, pp, MTOK)) = make_uint2(pk2(y.x, y.y), pk2(y.z, y.w));
      }
      if (a & 1) __builtin_amdgcn_sched_barrier(0);
    }
  } else if (EPI == 0) {
    u16* out = (u16*)ea.out;
#pragma unroll
    for (int b = 0; b < 4; ++b) {
      const size_t q = q0 + wq * 64 + b * 16 + l15;
#pragma unroll
      for (int a = 0; a < 8; ++a) {
        const int pp = p0 + wp * 128 + a * 16 + q4 * 4;
        f32x4 v = acc[a][b];
        *(uint2*)(out + q * ea.ldo + pp) = make_uint2(pk2(v[0], v[1]), pk2(v[2], v[3]));
      }
    }
  } else if (EPI == 1) {
    u16* out = (u16*)ea.out;
#pragma unroll
    for (int b = 0; b < 4; ++b) {
      const size_t q = q0 + wq * 64 + b * 16 + l15;
#pragma unroll
      for (int a = 0; a < 4; ++a) {
        const int f = ((p0 + wp * 128) >> 1) + a * 16 + q4 * 4;
        f32x4 g = acc[2 * a][b], u = acc[2 * a + 1][b];
        float r[4];
#pragma unroll
        for (int j = 0; j < 4; ++j) r[j] = g[j] / (1.f + __expf(-g[j])) * u[j];
        *(uint2*)(out + kb32(q, f, MTOK)) = make_uint2(pk2(r[0], r[1]), pk2(r[2], r[3]));
      }
    }
  } else {
    u16* out = (u16*)ea.out;
#pragma unroll
    for (int b = 0; b < 4; ++b) {
      const size_t q = q0 + wq * 64 + b * 16 + l15;
#pragma unroll
      for (int a = 0; a < 8; ++a) {
        const int pp = p0 + wp * 128 + a * 16 + q4 * 4;
        f32x4 v = acc[a][b];
        float4 cs = make_float4(ea.s, ea.s, ea.s, ea.s);
        if (ea.colscale) { float4 c = *(const float4*)(ea.colscale + pp); cs.x *= c.x; cs.y *= c.y; cs.z *= c.z; cs.w *= c.w; }
        *(uint2*)(out + q * ea.ldo + pp) = make_uint2(pk2(cs.x * v[0], cs.y * v[1]), pk2(cs.z * v[2], cs.w * v[3]));
      }
    }
  }
}

DEV void gemm_tile_coords(int t, int nPt, int nQt, bool pfast, int G, int& pi, int& qi) {
  const int nT = pfast ? nPt : nQt, nW = pfast ? nQt : nPt;
  int ti, wi;
  if ((nT & 63) == 0 && (G & 7) == 0) {
    const int x = t & 7, u = t >> 3;
    const int per = nW * 8;
    const int qgrp = u / per, rem = u - qgrp * per;
    wi = rem >> 3;
    ti = ((qgrp * 8 + (rem & 7)) << 3) + x;
  } else { ti = t % nT; wi = t / nT; }
  if (pfast) { pi = ti; qi = wi; } else { qi = ti; pi = wi; }
}

template <int EPI>
DEV void gemm_job(int& base, const u16* P, int ldp, int nPt, const u16* Q, int ldq, int nQt, int K, bool pfast,
                  const EpiArgs& ea, char* smem, size_t qofs_per_pi = 0) {
  const int nt = nPt * nQt, G = gridDim.x;
  const int first = ((int)blockIdx.x - (base % G) + G) % G;
  base += nt;
  if (first >= nt) return;
  int pi, qi;
  gemm_tile_coords(first, nPt, nQt, pfast, G, pi, qi);
  asm volatile("s_waitcnt vmcnt(0)" ::: "memory");
  __syncthreads();
  gemm_prime(P + (size_t)pi * 256 * 32, ldp, Q + (size_t)qi * 128 * 32 + (size_t)pi * qofs_per_pi, ldq, K, smem);
  int st = 0;
  for (int t = first; t < nt; t += G) {
    const u16* Pt = P + (size_t)pi * 256 * 32;
    const u16* Qt = Q + (size_t)qi * 128 * 32 + (size_t)pi * qofs_per_pi;
    const int p0 = pi * 256, q0 = qi * 128;
    const u16* Pn = nullptr; const u16* Qn = nullptr;
    if (t + G < nt) {
      gemm_tile_coords(t + G, nPt, nQt, pfast, G, pi, qi);
      Pn = P + (size_t)pi * 256 * 32;
      Qn = Q + (size_t)qi * 128 * 32 + (size_t)pi * qofs_per_pi;
    }
    f32x4 acc[8][4];
    gemm_mainloop(Pt, ldp, Qt, ldq, K, smem, acc, Pn, Qn, st);
    gemm_epilogue<EPI>(acc, p0, q0, ea, smem);
  }
  __builtin_amdgcn_s_barrier();
  asm volatile("" ::: "memory");
}

DEV void phase_ln(const Params& p, const float* g, const float* b, const u16* z, const float* xin) {
  const int tid = otid();
  const int wave = tid >> 6, lane = tid & 63;
  u16* xb = (u16*)(p.ws + OFF_XB);
  float4 gg[4], bb[4];
#pragma unroll
  for (int i = 0; i < 4; ++i) { gg[i] = *(const float4*)(g + i * 256 + lane * 4); bb[i] = *(const float4*)(b + i * 256 + lane * 4); }
  const int stride = gridDim.x * 8;
  int row0 = (blockIdx.x * 4 + wave) * 2;
  float4 nx[2][4];
  uint2 nz[2][4];
  if (row0 < MTOK) {
#pragma unroll
    for (int r = 0; r < 2; ++r)
#pragma unroll
      for (int i = 0; i < 4; ++i) {
        nx[r][i] = *(const float4*)(xin + (size_t)(row0 + r) * 1024 + i * 256 + lane * 4);
        nz[r][i] = *(const uint2*)(z + (size_t)(row0 + r) * 1024 + i * 256 + lane * 4);
      }
  }
  for (; row0 < MTOK; row0 += stride) {
    float4 v[2][4];
#pragma unroll
    for (int r = 0; r < 2; ++r)
#pragma unroll
      for (int i = 0; i < 4; ++i) {
        v[r][i].x = ALPHA * nx[r][i].x + bflo(nz[r][i].x);
        v[r][i].y = ALPHA * nx[r][i].y + bfhi(nz[r][i].x);
        v[r][i].z = ALPHA * nx[r][i].z + bflo(nz[r][i].y);
        v[r][i].w = ALPHA * nx[r][i].w + bfhi(nz[r][i].y);
      }
    if (row0 + stride < MTOK) {
#pragma unroll
      for (int r = 0; r < 2; ++r)
#pragma unroll
        for (int i = 0; i < 4; ++i) {
          nx[r][i] = *(const float4*)(xin + (size_t)(row0 + stride + r) * 1024 + i * 256 + lane * 4);
          nz[r][i] = *(const uint2*)(z + (size_t)(row0 + stride + r) * 1024 + i * 256 + lane * 4);
        }
    }
#pragma unroll
    for (int r = 0; r < 2; ++r) {
      float s = 0.f;
#pragma unroll
      for (int i = 0; i < 4; ++i) s += v[r][i].x + v[r][i].y + v[r][i].z + v[r][i].w;
#pragma unroll
      for (int o = 32; o > 0; o >>= 1) s += __shfl_xor(s, o);
      const float mu = s * (1.f / 1024.f);
      float ss = 0.f;
#pragma unroll
      for (int i = 0; i < 4; ++i) {
        v[r][i].x -= mu; v[r][i].y -= mu; v[r][i].z -= mu; v[r][i].w -= mu;
        ss += v[r][i].x * v[r][i].x + v[r][i].y * v[r][i].y + v[r][i].z * v[r][i].z + v[r][i].w * v[r][i].w;
      }
#pragma unroll
      for (int o = 32; o > 0; o >>= 1) ss += __shfl_xor(ss, o);
      const float rs = rsqrtf(ss * (1.f / 1024.f) + 1e-5f);
      float* xr = p.xf + (size_t)(row0 + r) * 1024;
#pragma unroll
      for (int i = 0; i < 4; ++i) {
        const int c = i * 256 + lane * 4;
        float4 y;
        y.x = v[r][i].x * rs * gg[i].x + bb[i].x;
        y.y = v[r][i].y * rs * gg[i].y + bb[i].y;
        y.z = v[r][i].z * rs * gg[i].z + bb[i].z;
        y.w = v[r][i].w * rs * gg[i].w + bb[i].w;
        *(float4*)(xr + c) = y;
        *(uint2*)(xb + kb32(row0 + r, c, MTOK)) = make_uint2(pk2(y.x, y.y), pk2(y.z, y.w));
      }
    }
  }
}

constexpr int VSTR = 144;

template <int D>
DEV void load_kv_tile(const u16* __restrict__ kptr, size_t ldk, const u16* __restrict__ vtptr, size_t ldv, char* Ks,
                      char* Vs) {
  constexpr int KSTR = D * 2 + 16;
  constexpr int CPR = D / 8;
  const int tid = otid();
#pragma unroll
  for (int i = 0; i < D / 32; ++i) {
    int c = tid + 256 * i;
    int row = c / CPR, kc = c % CPR;
    uint4 v = *(const uint4*)(kptr + (size_t)row * ldk + kc * 8);
    *(uint4*)(Ks + row * KSTR + kc * 16) = v;
  }
#pragma unroll
  for (int i = 0; i < D / 32; ++i) {
    int c = tid + 256 * i;
    int d = c >> 3, kc = c & 7;
    uint4 v = *(const uint4*)(vtptr + (size_t)d * ldv + kc * 8);
    *(uint4*)(Vs + d * VSTR + kc * 16) = v;
  }
}

DEV int dense_gk(int r) { const int i = (r & 15) >> 1; return i ^ (((i + 2) >> 2) & 1); }
DEV int dense_gv(int d) { return (d >> 1) & 7; }
DEV void dma_kv_tile(const u16* __restrict__ kptr, size_t ldk, const u16* __restrict__ vtptr, size_t ldv, char* Kb,
                     char* Vb, int tid) {
#pragma unroll
  for (int j = 0; j < 2; ++j) {
    const int L = tid + 256 * j, row = L >> 3, cp = L & 7;
    __builtin_amdgcn_global_load_lds((const unsigned*)(kptr + (size_t)row * ldk + ((cp ^ dense_gk(row)) * 8)),
                                     (unsigned*)(Kb + L * 16), 16, 0, 0);
    __builtin_amdgcn_global_load_lds((const unsigned*)(vtptr + (size_t)row * ldv + ((cp ^ dense_gv(row)) * 8)),
                                     (unsigned*)(Vb + L * 16), 16, 0, 0);
  }
}

template <int D, int RT, bool DENSE, class F>
DEV void flash_block(f32x4 (&o)[RT][D / 16], float (&m)[RT], float (&l)[RT], const bf16x8 (&qf)[RT][D / 32],
                     const char* Ks, const char* Vs, const F& f) {
  constexpr int KSTR = D * 2 + 16;
  const int lane = otid() & 63, l15 = lane & 15, q4 = lane >> 4;
  const int gkl = dense_gk(l15), gvl = dense_gv(l15);
  f32x4 s[RT][4];
#pragma unroll
  for (int ks = 0; ks < 4; ++ks) {
#pragma unroll
    for (int rt = 0; rt < RT; ++rt) {
      s[rt][ks][0] = f.init(rt, ks * 16 + 0); s[rt][ks][1] = f.init(rt, ks * 16 + 1);
      s[rt][ks][2] = f.init(rt, ks * 16 + 2); s[rt][ks][3] = f.init(rt, ks * 16 + 3);
    }
#pragma unroll
    for (int ds = 0; ds < D / 32; ++ds) {
      bf16x8 kf = DENSE ? *(const bf16x8*)(Ks + (ks * 16 + l15) * 128 + (((ds * 4 + q4) ^ gkl) * 16))
                        : *(const bf16x8*)(Ks + (ks * 16 + l15) * KSTR + ds * 64 + q4 * 16);
#pragma unroll
      for (int rt = 0; rt < RT; ++rt) s[rt][ks] = MFMA16(kf, qf[rt][ds], s[rt][ks]);
    }
    if (D > 64) __builtin_amdgcn_sched_barrier(0);
  }
#pragma unroll
  for (int rt = 0; rt < RT; ++rt) {
    float mx = fmaxf(fmaxf(s[rt][0][0], s[rt][0][1]), fmaxf(s[rt][0][2], s[rt][0][3]));
#pragma unroll
    for (int ks = 1; ks < 4; ++ks) mx = fmaxf(mx, fmaxf(fmaxf(s[rt][ks][0], s[rt][ks][1]), fmaxf(s[rt][ks][2], s[rt][ks][3])));
    mx = fmaxf(mx, __shfl_xor(mx, 16));
    mx = fmaxf(mx, __shfl_xor(mx, 32));
    const float mn = fmaxf(m[rt], mx);
    const float a = __builtin_amdgcn_exp2f(m[rt] - mn);
    m[rt] = mn;
    float ls = 0.f;
#pragma unroll
    for (int ks = 0; ks < 4; ++ks)
#pragma unroll
      for (int j = 0; j < 4; ++j) {
        const float pv = __builtin_amdgcn_exp2f(s[rt][ks][j] - mn);
        ls += pv;
        s[rt][ks][j] = pv;
      }
    l[rt] = l[rt] * a + ls;
    if (__any(a != 1.f)) {
#pragma unroll
      for (int dd = 0; dd < D / 16; ++dd) {
        o[rt][dd][0] *= a; o[rt][dd][1] *= a; o[rt][dd][2] *= a; o[rt][dd][3] *= a;
      }
    }
  }
#pragma unroll
  for (int kh = 0; kh < 2; ++kh) {
    bf16x8 pf[RT];
#pragma unroll
    for (int rt = 0; rt < RT; ++rt) {
      uint4 w;
      w.x = pk2(s[rt][2 * kh][0], s[rt][2 * kh][1]);
      w.y = pk2(s[rt][2 * kh][2], s[rt][2 * kh][3]);
      w.z = pk2(s[rt][2 * kh + 1][0], s[rt][2 * kh + 1][1]);
      w.w = pk2(s[rt][2 * kh + 1][2], s[rt][2 * kh + 1][3]);
      pf[rt] = __builtin_bit_cast(bf16x8, w);
    }
#pragma unroll
    for (int dd = 0; dd < D / 16; ++dd) {
      uint2 v0, v1;
      if (DENSE) {
        const char* vr = Vs + (dd * 16 + l15) * 128 + (q4 & 1) * 8;
        v0 = *(const uint2*)(vr + (((4 * kh + (q4 >> 1)) ^ gvl) * 16));
        v1 = *(const uint2*)(vr + (((4 * kh + 2 + (q4 >> 1)) ^ gvl) * 16));
      } else {
        const char* vp = Vs + (dd * 16 + l15) * VSTR + (32 * kh + q4 * 4) * 2;
        v0 = *(const uint2*)(vp);
        v1 = *(const uint2*)(vp + 32);
      }
      uint4 w = make_uint4(v0.x, v0.y, v1.x, v1.y);
      bf16x8 vf = __builtin_bit_cast(bf16x8, w);
#pragma unroll
      for (int rt = 0; rt < RT; ++rt) o[rt][dd] = MFMA16(vf, pf[rt], o[rt][dd]);
      if (D > 64 && (dd & 3) == 3) __builtin_amdgcn_sched_barrier(0);
    }
  }
}

template <int RT>
DEV void flash_finish_l(float (&l)[RT]) {
#pragma unroll
  for (int rt = 0; rt < RT; ++rt) {
    float v = l[rt];
    v += __shfl_xor(v, 16);
    v += __shfl_xor(v, 32);
    l[rt] = v;
  }
}

constexpr float NEG_INF = -__builtin_huge_valf();
struct FNoMask {
  DEV float init(int, int) const { return 0.f; }
};
template <bool MASKED>
struct FBand {
  float dq[2];
  float sd[2];
  float slope[2];
  float W;
  DEV float init(int rt, int c) const {
    const float bias = __builtin_fmaf(slope[rt], (float)c, -sd[rt]);
    if (!MASKED) return bias;
    const float d = dq[rt] - (float)c;
    return (d >= 0.f && d < W) ? bias : NEG_INF;
  }
};
template <bool MASKED>
struct FSel {
  float dq[2];
  float sd[2];
  float slope[2];
  DEV float init(int rt, int c) const {
    const float bias = __builtin_fmaf(slope[rt], (float)c, -sd[rt]);
    if (!MASKED) return bias;
    return (dq[rt] - (float)c >= 0.f) ? bias : NEG_INF;
  }
};

DEV void phase_swa_attn(const Params& p, char* smem) {
  const u16* proj = (const u16*)(p.ws + OFF_BIG);
  const u16* vt = (const u16*)(p.ws + OFF_BIG + BIG_VT2);
  u16* ao = (u16*)(p.ws + OFF_AO);
  const float* sinks = p.in[14];
  const int tid = otid();
  const int lane = tid & 63, wave = tid >> 6, l15 = lane & 15, q4 = lane >> 4;
  for (int item = blockIdx.x; item < 16 * 4 * 64; item += gridDim.x) {
    const int tb = item & 63, g = (item >> 6) & 3, b = item >> 8;
    const int t0 = tb * 32;
    bf16x8 qf[2][2];
    f32x4 o[2][4];
    float m[2], l[2], slope[2];
    int head[2], tokr[2];
#pragma unroll
    for (int rt = 0; rt < 2; ++rt) {
      const int r = wave * 32 + rt * 16 + l15;
      tokr[rt] = t0 + (r >> 2);
      head[rt] = g * 4 + (r & 3);
      slope[rt] = LOG2E * exp2f(-0.5f * (float)(head[rt] + 1));
      const u16* qp = proj + (size_t)(b * SEQL + tokr[rt]) * 1280 + head[rt] * 64 + q4 * 8;
      qf[rt][0] = *(const bf16x8*)(qp);
      qf[rt][1] = *(const bf16x8*)(qp + 32);
      m[rt] = LOG2E * sinks[head[rt]];
      l[rt] = (q4 == 0) ? 1.f : 0.f;
#pragma unroll
      for (int dd = 0; dd < 4; ++dd) o[rt][dd] = f32x4{0.f, 0.f, 0.f, 0.f};
    }
    int kb0 = t0 - 127; kb0 = kb0 < 0 ? 0 : (kb0 & ~63);
    const int kb1 = t0 & ~63;
    __syncthreads();
    dma_kv_tile(proj + (size_t)(b * SEQL + kb1) * 1280 + 1024 + g * 64, 1280,
                vt + (size_t)(g * 64) * MTOK + b * SEQL + kb1, MTOK, smem, smem + 8192, tid);
    int bufi = 0;
    for (int kb = kb1; kb >= kb0; kb -= 64) {
      asm volatile("s_waitcnt vmcnt(0)" ::: "memory");
      __syncthreads();
      if (kb - 64 >= kb0)
        dma_kv_tile(proj + (size_t)(b * SEQL + kb - 64) * 1280 + 1024 + g * 64, 1280,
                    vt + (size_t)(g * 64) * MTOK + b * SEQL + kb - 64, MTOK, smem + (bufi ^ 1) * 16384,
                    smem + (bufi ^ 1) * 16384 + 8192, tid);
      const bool full = (t0 - (kb + 63) >= 0) && (t0 + 31 - kb < 128);
      const float dq0 = (float)(tokr[0] - kb - q4 * 4), dq1 = (float)(tokr[1] - kb - q4 * 4);
      if (full) {
        FBand<false> f{{dq0, dq1}, {slope[0] * dq0, slope[1] * dq1}, {slope[0], slope[1]}, 128.f};
        flash_block<64, 2, true>(o, m, l, qf, smem + bufi * 16384, smem + bufi * 16384 + 8192, f);
      } else {
        FBand<true> f{{dq0, dq1}, {slope[0] * dq0, slope[1] * dq1}, {slope[0], slope[1]}, 128.f};
        flash_block<64, 2, true>(o, m, l, qf, smem + bufi * 16384, smem + bufi * 16384 + 8192, f);
      }
      bufi ^= 1;
    }
    flash_finish_l<2>(l);
#pragma unroll
    for (int rt = 0; rt < 2; ++rt) {
      const float inv = 1.f / l[rt];
#pragma unroll
      for (int dd = 0; dd < 4; ++dd) {
        f32x4 v = o[rt][dd];
        *(uint2*)(ao + kb32((size_t)(b * SEQL + tokr[rt]), head[rt] * 64 + dd * 16 + q4 * 4, MTOK)) =
            make_uint2(pk2(v[0] * inv, v[1] * inv), pk2(v[2] * inv, v[3] * inv));
      }
    }
  }
}

DEV void phase_xattn(const Params& p, char* smem) {
  const u16* qb = (const u16*)(p.ws + OFF_BIG);
  const u16* kbuf = (const u16*)(p.ws + OFF_KB);
  const u16* vtb = (const u16*)(p.ws + OFF_VT);
  u16* ao = (u16*)(p.ws + OFF_AO);
  char* Ks = smem; char* Vs = smem + 64 * (512 + 16);
  const int lane = otid() & 63, wave = otid() >> 6, l15 = lane & 15, q4 = lane >> 4;
  FNoMask f;
  for (int item = blockIdx.x; item < 16 * 4 * 32; item += gridDim.x) {
    const int tb = item & 31, h = (item >> 5) & 3, b = item >> 7;
    const int tok = tb * 64 + wave * 16 + l15;
    bf16x8 qf[1][8];
    f32x4 o[1][16];
    float m[1], l[1];
    const u16* qp = qb + (size_t)(b * SEQL + tok) * 1024 + h * 256 + q4 * 8;
#pragma unroll
    for (int ds = 0; ds < 8; ++ds) qf[0][ds] = *(const bf16x8*)(qp + ds * 32);
#pragma unroll
    for (int dd = 0; dd < 16; ++dd) o[0][dd] = f32x4{0.f, 0.f, 0.f, 0.f};
    m[0] = NEGBIG; l[0] = 0.f;
    for (int kb = 0; kb < 256; kb += 64) {
      __syncthreads();
      load_kv_tile<256>(kbuf + (size_t)(b * 256 + kb) * 1024 + h * 256, 1024,
                        vtb + (size_t)(h * 256) * 4096 + b * 256 + kb, 4096, Ks, Vs);
      __syncthreads();
      flash_block<256, 1, false>(o, m, l, qf, Ks, Vs, f);
    }
    flash_finish_l<1>(l);
    const float inv = 1.f / l[0];
#pragma unroll
    for (int dd = 0; dd < 16; ++dd) {
      f32x4 v = o[0][dd];
      *(uint2*)(ao + kb32((size_t)(b * SEQL + tok), h * 256 + dd * 16 + q4 * 4, MTOK)) =
          make_uint2(pk2(v[0] * inv, v[1] * inv), pk2(v[2] * inv, v[3] * inv));
    }
  }
}

DEV float gelu_tanh(float x) {
  float u = 0.7978845608028654f * (x + 0.044715f * x * x * x);
  return 0.5f * x * (1.f + tanhf(u));
}
constexpr int NSA_LD = 1792;
DEV void phase_nsa_compress(const Params& p, char* smem) {
  const u16* proj = (const u16*)(p.ws + OFF_BIG);
  u16* cmpb = (u16*)(p.ws + OFF_CMP);
  const float* pos = p.in[17];
  const float* w1 = p.in[18];
  const float* w2 = p.in[19];
  float* in_s = (float*)smem;
  float* red_s = in_s + 144 * 64;
  float* hid_s = red_s + 4 * 8 * 64;
  const int tid = otid(), e = tid & 63, part = tid >> 6;
  for (int item = blockIdx.x; item < 2 * 16 * 2 * 16; item += gridDim.x) {
    const int ng = item & 15, g = (item >> 4) & 1, b = (item >> 5) & 15, which = item >> 9;
    const int n0 = ng * 8;
    const int cnt = (127 - n0) < 8 ? (127 - n0) : 8;
    const int tbase = 16 * n0;
    const int coff = 1024 + which * 128 + g * 64;
    __syncthreads();
    for (int idx = tid; idx < 144 * 8; idx += 256) {
      const int row = idx >> 3, c8 = idx & 7;
      const int t = tbase + row;
      float vals[8];
      if (t < SEQL) {
        uint4 v = *(const uint4*)(proj + (size_t)(b * SEQL + t) * NSA_LD + coff + c8 * 8);
        vals[0] = bflo(v.x); vals[1] = bfhi(v.x); vals[2] = bflo(v.y); vals[3] = bfhi(v.y);
        vals[4] = bflo(v.z); vals[5] = bfhi(v.z); vals[6] = bflo(v.w); vals[7] = bfhi(v.w);
      } else {
#pragma unroll
        for (int j = 0; j < 8; ++j) vals[j] = 0.f;
      }
#pragma unroll
      for (int j = 0; j < 8; ++j) in_s[row * 64 + c8 * 8 + j] = vals[j];
    }
    __syncthreads();
    float acc[8];
#pragma unroll
    for (int nn = 0; nn < 8; ++nn) acc[nn] = 0.f;
    float accp = 0.f;
    for (int l = part * 8; l < part * 8 + 8; ++l) {
      const float* wrow = w1 + ((size_t)(which * 32 + l) * 64) * 64 + e;
      const float* prow = pos + (which * 32 + l) * 64;
#pragma unroll 4
      for (int d = 0; d < 64; ++d) {
        const float w = wrow[d * 64];
        accp += prow[d] * w;
#pragma unroll
        for (int nn = 0; nn < 8; ++nn) acc[nn] += in_s[(16 * nn + l) * 64 + d] * w;
      }
    }
#pragma unroll
    for (int nn = 0; nn < 8; ++nn) red_s[(part * 8 + nn) * 64 + e] = acc[nn] + accp;
    __syncthreads();
#pragma unroll
    for (int h2 = 0; h2 < 2; ++h2) {
      const int nn = part + 4 * h2;
      float hsum = red_s[(0 * 8 + nn) * 64 + e] + red_s[(1 * 8 + nn) * 64 + e] + red_s[(2 * 8 + nn) * 64 + e] +
                   red_s[(3 * 8 + nn) * 64 + e];
      hid_s[nn * 64 + e] = gelu_tanh(hsum);
    }
    __syncthreads();
#pragma unroll
    for (int h2 = 0; h2 < 2; ++h2) {
      const int nn = part + 4 * h2;
      float s = 0.f;
      const float* w2p = w2 + (size_t)which * 4096 + e;
#pragma unroll 8
      for (int k = 0; k < 64; ++k) s += hid_s[nn * 64 + k] * w2p[k * 64];
      {
        const float sv = (nn < cnt) ? s : 0.f;
        const size_t bg = (size_t)b * 2 + g;
        if (which == 0) cmpb[(bg * 128 + n0 + nn) * 64 + e] = f2bf(sv);
        else cmpb[(size_t)32 * 128 * 64 + (bg * 64 + e) * 128 + n0 + nn] = f2bf(sv);
      }
    }
  }
}

struct FCmp {
  float nq[2];
  float bq[2];
  float slope16[2];
  DEV float init(int rt, int c) const {
    return ((float)c <= nq[rt]) ? __builtin_fmaf(slope16[rt], (float)c, bq[rt]) : NEG_INF;
  }
};

DEV void phase_nsa_attn(const Params& p, char* smem) {
  const u16* proj = (const u16*)(p.ws + OFF_BIG);
  const u16* vt = (const u16*)(p.ws + OFF_BIG + BIG_VT2);
  const u16* kcb = (const u16*)(p.ws + OFF_CMP);
  const u16* vcb = kcb + (size_t)32 * 128 * 64;
  u16* ao = (u16*)(p.ws + OFF_AO);
  char* KC = smem + 32768;
  float* impA = (float*)(smem + 49152);
  float* impC = (float*)(smem + 51200);
  u32* selm = (u32*)(smem + 53248);
  const int tid = otid();
  const int lane = tid & 63, wave = tid >> 6, l15 = lane & 15, q4 = lane >> 4;
  for (int item = blockIdx.x; item < 16 * 2 * 128; item += gridDim.x) {
    const int tbr_ = item & 127;
    const int tb = (item & 512) ? 127 - tbr_ : tbr_, g = (item >> 7) & 1, b = item >> 8;
    const int t0 = tb * 16;
    bf16x8 qf[2][2];
    int head[2], tokr[2];
    float slope[2];
#pragma unroll
    for (int rt = 0; rt < 2; ++rt) {
      const int r = wave * 32 + rt * 16 + l15;
      tokr[rt] = t0 + (r >> 3);
      head[rt] = g * 8 + (r & 7);
      slope[rt] = LOG2E * exp2f(-0.5f * (float)(head[rt] + 1));
      const u16* qp = proj + (size_t)(b * SEQL + tokr[rt]) * NSA_LD + head[rt] * 64 + q4 * 8;
      qf[rt][0] = *(const bf16x8*)(qp);
      qf[rt][1] = *(const bf16x8*)(qp + 32);
    }
    {
      f32x4 base[2][4];
      {
        f32x4 o[2][4];
        float m[2], l[2];
#pragma unroll
        for (int rt = 0; rt < 2; ++rt) {
          m[rt] = NEGBIG; l[rt] = 0.f;
#pragma unroll
          for (int dd = 0; dd < 4; ++dd) o[rt][dd] = f32x4{0.f, 0.f, 0.f, 0.f};
        }
        const int nvmax = (t0 + 15 >= 31) ? ((t0 + 15 - 31) >> 4) + 1 : 0;
        const int nkb = (nvmax + 63) >> 6;
        __syncthreads();
        for (int i = tid; i < 1024; i += 256) impA[i] = 0.f;
        for (int kb = 0; kb < nkb; ++kb)
          dma_kv_tile(kcb + (((size_t)b * 2 + g) * 128 + kb * 64) * 64, 64,
                      vcb + ((size_t)b * 2 + g) * 64 * 128 + kb * 64, 128, KC + kb * 8192, smem + kb * 16384 + 8192, tid);
        asm volatile("s_waitcnt vmcnt(0)" ::: "memory");
        __syncthreads();
        FCmp fc;
        float nvl[2];
#pragma unroll
        for (int rt = 0; rt < 2; ++rt) {
          nvl[rt] = (tokr[rt] >= 31) ? (float)((tokr[rt] - 31) >> 4) : -1.f;
          fc.slope16[rt] = 16.f * slope[rt];
        }
        for (int kb = 0; kb < nkb; ++kb) {
#pragma unroll
          for (int rt = 0; rt < 2; ++rt) {
            const float nb = (float)(kb * 64 + q4 * 4);
            fc.nq[rt] = nvl[rt] - nb;
            fc.bq[rt] = fc.slope16[rt] * nb - slope[rt] * ((float)tokr[rt] - 15.5f);
          }
          flash_block<64, 2, true>(o, m, l, qf, KC + kb * 8192, smem + kb * 16384 + 8192, fc);
        }
        flash_finish_l<2>(l);
        float linv[2];
#pragma unroll
        for (int rt = 0; rt < 2; ++rt) {
          linv[rt] = (l[rt] > 0.f) ? 1.f / l[rt] : 0.f;
          const float sc = linv[rt] / (1.f + __expf(-bf2f(proj[(size_t)(b * SEQL + tokr[rt]) * NSA_LD + 1536 + head[rt]])));
#pragma unroll
          for (int dd = 0; dd < 4; ++dd) {
            base[rt][dd][0] = o[rt][dd][0] * sc; base[rt][dd][1] = o[rt][dd][1] * sc;
            base[rt][dd][2] = o[rt][dd][2] * sc; base[rt][dd][3] = o[rt][dd][3] * sc;
          }
        }
        for (int kb = 0; kb < nkb; ++kb) {
          const char* Kc = KC + kb * 8192;
          const int gkl = dense_gk(l15);
#pragma unroll
          for (int rt = 0; rt < 2; ++rt) {
            const float nb = (float)(kb * 64 + q4 * 4);
            fc.nq[rt] = nvl[rt] - nb;
            fc.bq[rt] = fc.slope16[rt] * nb - slope[rt] * ((float)tokr[rt] - 15.5f);
          }
#pragma unroll
          for (int ks = 0; ks < 4; ++ks) {
            f32x4 s[2];
#pragma unroll
            for (int rt = 0; rt < 2; ++rt) {
              s[rt][0] = fc.init(rt, ks * 16 + 0); s[rt][1] = fc.init(rt, ks * 16 + 1);
              s[rt][2] = fc.init(rt, ks * 16 + 2); s[rt][3] = fc.init(rt, ks * 16 + 3);
            }
#pragma unroll
            for (int ds = 0; ds < 2; ++ds) {
              bf16x8 kf = *(const bf16x8*)(Kc + (ks * 16 + l15) * 128 + (((ds * 4 + q4) ^ gkl) * 16));
              s[0] = MFMA16(kf, qf[0][ds], s[0]);
              s[1] = MFMA16(kf, qf[1][ds], s[1]);
            }
#pragma unroll
            for (int rt = 0; rt < 2; ++rt) {
              float pa = 0.f, pc = 0.f;
#pragma unroll
              for (int j = 0; j < 4; ++j) {
                const float pr = __builtin_amdgcn_exp2f(s[rt][j] - m[rt]) * linv[rt];
                pa += pr;
                if (j == 3) pc = pr;
              }
              pa += __shfl_xor(pa, 1); pa += __shfl_xor(pa, 2); pa += __shfl_xor(pa, 4);
              pc += __shfl_xor(pc, 1); pc += __shfl_xor(pc, 2); pc += __shfl_xor(pc, 4);
              if ((l15 & 7) == 0) {
                const int tk = wave * 4 + rt * 2 + (l15 >> 3);
                const int a = kb * 16 + ks * 4 + q4;
                impA[tk * 32 + a] = pa;
                impC[tk * 32 + a] = pc;
              }
            }
          }
        }
      }
      __syncthreads();
      {
        const int tk = tid >> 4, mb2 = tid & 15;
        const int t = t0 + tk;
        const int cur = t >> 6;
        float sc2[2];
#pragma unroll
        for (int mm = 0; mm < 2; ++mm) {
          const int mb = mb2 * 2 + mm;
          const bool fm = (mb == 0) || (mb == cur) || (mb == cur - 1);
          sc2[mm] = (mb <= cur) ? impA[tk * 32 + mb] + (mb > 0 ? impC[tk * 32 + mb - 1] : 0.f) + (fm ? 1.0e4f : 0.f) : -1.f;
        }
        __syncthreads();
        impA[tk * 32 + mb2 * 2] = sc2[0];
        impA[tk * 32 + mb2 * 2 + 1] = sc2[1];
        __syncthreads();
        u32 bits = 0;
#pragma unroll
        for (int mm = 0; mm < 2; ++mm) {
          const int mb = mb2 * 2 + mm;
          if (mb <= cur) {
            const float sm = sc2[mm];
            int rank = 0;
            for (int m2 = 0; m2 <= cur; ++m2) {
              const float s2 = impA[tk * 32 + m2];
              rank += (s2 > sm || (s2 == sm && m2 < mb)) ? 1 : 0;
            }
            if (rank < 8) bits |= (1u << mb);
          }
        }
        bits |= __shfl_xor(bits, 1);
        bits |= __shfl_xor(bits, 2);
        bits |= __shfl_xor(bits, 4);
        bits |= __shfl_xor(bits, 8);
        if (mb2 == 0) selm[tk] = bits;
      }
#pragma unroll
      for (int rt = 0; rt < 2; ++rt)
#pragma unroll
        for (int dd = 0; dd < 4; ++dd)
          *(uint2*)(KC + (wave * 32 + rt * 16 + l15) * 128 + dd * 32 + q4 * 8) =
              make_uint2(pk2(base[rt][dd][0], base[rt][dd][1]), pk2(base[rt][dd][2], base[rt][dd][3]));
    }
    __syncthreads();
    u32 um = 0;
#pragma unroll
    for (int i = 0; i < 16; ++i) um |= selm[i];
    u32 rmask[2];
#pragma unroll
    for (int rt = 0; rt < 2; ++rt) rmask[rt] = selm[wave * 4 + rt * 2 + (l15 >> 3)];
    const int curb = t0 >> 6;
    {
      f32x4 o[2][4];
      float m[2], l[2];
#pragma unroll
      for (int rt = 0; rt < 2; ++rt) {
        m[rt] = NEGBIG; l[rt] = 0.f;
#pragma unroll
        for (int dd = 0; dd < 4; ++dd) o[rt][dd] = f32x4{0.f, 0.f, 0.f, 0.f};
      }
      u32 rem = um;
      int mb = 31 - __builtin_clz(rem);
      rem &= ~(1u << mb);
      __syncthreads();
      dma_kv_tile(proj + (size_t)(b * SEQL + mb * 64) * NSA_LD + 1280 + g * 64, NSA_LD,
                  vt + (size_t)(g * 64) * MTOK + b * SEQL + mb * 64, MTOK, smem, smem + 8192, tid);
      int bufi = 0;
      for (;;) {
        asm volatile("s_waitcnt vmcnt(0)" ::: "memory");
        __syncthreads();
        const int mbn = rem ? 31 - __builtin_clz(rem) : -1;
        if (mbn >= 0)
          dma_kv_tile(proj + (size_t)(b * SEQL + mbn * 64) * NSA_LD + 1280 + g * 64, NSA_LD,
                      vt + (size_t)(g * 64) * MTOK + b * SEQL + mbn * 64, MTOK, smem + (bufi ^ 1) * 16384,
                      smem + (bufi ^ 1) * 16384 + 8192, tid);
        const float dq0 = (float)(tokr[0] - mb * 64 - q4 * 4), dq1 = (float)(tokr[1] - mb * 64 - q4 * 4);
        const float sd0 = ((rmask[0] >> mb) & 1u) ? slope[0] * dq0 : -NEG_INF;
        const float sd1 = ((rmask[1] >> mb) & 1u) ? slope[1] * dq1 : -NEG_INF;
        if (mb < curb) {
          FSel<false> f{{dq0, dq1}, {sd0, sd1}, {slope[0], slope[1]}};
          flash_block<64, 2, true>(o, m, l, qf, smem + bufi * 16384, smem + bufi * 16384 + 8192, f);
        } else {
          FSel<true> f{{dq0, dq1}, {sd0, sd1}, {slope[0], slope[1]}};
          flash_block<64, 2, true>(o, m, l, qf, smem + bufi * 16384, smem + bufi * 16384 + 8192, f);
        }
        if (mbn < 0) break;
        rem &= ~(1u << mbn);
        mb = mbn;
        bufi ^= 1;
      }
      flash_finish_l<2>(l);
#pragma unroll
      for (int rt = 0; rt < 2; ++rt) {
        const float sc = 1.f / ((1.f + __expf(-bf2f(proj[(size_t)(b * SEQL + tokr[rt]) * NSA_LD + 1536 + 16 + head[rt]]))) * l[rt]);
#pragma unroll
        for (int dd = 0; dd < 4; ++dd) {
          uint2* bp = (uint2*)(KC + (wave * 32 + rt * 16 + l15) * 128 + dd * 32 + q4 * 8);
          const uint2 c = *bp;
          *bp = make_uint2(pk2(bflo(c.x) + o[rt][dd][0] * sc, bfhi(c.x) + o[rt][dd][1] * sc),
                           pk2(bflo(c.y) + o[rt][dd][2] * sc, bfhi(c.y) + o[rt][dd][3] * sc));
        }
      }
    }
    {
      f32x4 o[2][4];
      float m[2], l[2];
#pragma unroll
      for (int rt = 0; rt < 2; ++rt) {
        m[rt] = NEGBIG; l[rt] = 0.f;
#pragma unroll
        for (int dd = 0; dd < 4; ++dd) o[rt][dd] = f32x4{0.f, 0.f, 0.f, 0.f};
      }
      int kb0 = t0 - 511; kb0 = kb0 < 0 ? 0 : (kb0 & ~63);
      const int kb1 = t0 & ~63;
      __syncthreads();
      dma_kv_tile(proj + (size_t)(b * SEQL + kb1) * NSA_LD + 1408 + g * 64, NSA_LD,
                  vt + (size_t)(128 + g * 64) * MTOK + b * SEQL + kb1, MTOK, smem, smem + 8192, tid);
      int bufi = 0;
      for (int kb = kb1; kb >= kb0; kb -= 64) {
        asm volatile("s_waitcnt vmcnt(0)" ::: "memory");
        __syncthreads();
        if (kb - 64 >= kb0)
          dma_kv_tile(proj + (size_t)(b * SEQL + kb - 64) * NSA_LD + 1408 + g * 64, NSA_LD,
                      vt + (size_t)(128 + g * 64) * MTOK + b * SEQL + kb - 64, MTOK, smem + (bufi ^ 1) * 16384,
                      smem + (bufi ^ 1) * 16384 + 8192, tid);
        const bool full = (t0 - (kb + 63) >= 0) && (t0 + 15 - kb < 512);
        const float dq0 = (float)(tokr[0] - kb - q4 * 4), dq1 = (float)(tokr[1] - kb - q4 * 4);
        if (full) {
          FBand<false> f{{dq0, dq1}, {slope[0] * dq0, slope[1] * dq1}, {slope[0], slope[1]}, 512.f};
          flash_block<64, 2, true>(o, m, l, qf, smem + bufi * 16384, smem + bufi * 16384 + 8192, f);
        } else {
          FBand<true> f{{dq0, dq1}, {slope[0] * dq0, slope[1] * dq1}, {slope[0], slope[1]}, 512.f};
          flash_block<64, 2, true>(o, m, l, qf, smem + bufi * 16384, smem + bufi * 16384 + 8192, f);
        }
        bufi ^= 1;
      }
      flash_finish_l<2>(l);
#pragma unroll
      for (int rt = 0; rt < 2; ++rt) {
        const size_t tokg = (size_t)(b * SEQL + tokr[rt]);
        const float sc = 1.f / ((1.f + __expf(-bf2f(proj[tokg * NSA_LD + 1536 + 32 + head[rt]]))) * l[rt]);
#pragma unroll
        for (int dd = 0; dd < 4; ++dd) {
          const uint2 c = *(const uint2*)(KC + (wave * 32 + rt * 16 + l15) * 128 + dd * 32 + q4 * 8);
          float r0 = bflo(c.x) + o[rt][dd][0] * sc;
          float r1 = bfhi(c.x) + o[rt][dd][1] * sc;
          float r2 = bflo(c.y) + o[rt][dd][2] * sc;
          float r3 = bfhi(c.y) + o[rt][dd][3] * sc;
          *(uint2*)(ao + kb32(tokg, head[rt] * 64 + dd * 16 + q4 * 4, MTOK)) = make_uint2(pk2(r0, r1), pk2(r2, r3));
        }
      }
    }
  }
}

constexpr int GLA_LD = 2304;
constexpr int GQSTR = 272;
constexpr int BSTR = 129;
DEV void phase_gla_g1(const Params& p, char* smem) {
  u16* proj = (u16*)(p.ws + OFF_BIG);
  u16* ktg = (u16*)(p.ws + OFF_KT);
  u16* attb = (u16*)(p.ws + OFF_ATT);
  float* gd = (float*)(p.ws + OFF_GD);
  const float* wg2 = p.in[22];
  const float* bgate = p.in[23];
  float* b_s = (float*)smem;
  char* qe_s = smem + 33024;
  char* ke_s = qe_s + 64 * GQSTR;
  float* glr_s = (float*)(smem + 33024);
  float* w2_s = glr_s + 64 * 16;
  const int tid = otid(), lane = tid & 63, wave = tid >> 6, l15 = lane & 15, q4 = lane >> 4;
  for (int item = blockIdx.x; item < 2048; item += gridDim.x) {
    const int c = item & 31, h = (item >> 5) & 3, b = item >> 7;
    const size_t T0 = (size_t)b * SEQL + c * 64;
    __syncthreads();
    for (int i = tid; i < 64 * 16; i += 256) glr_s[i] = bf2f(proj[(T0 + (i >> 4)) * GLA_LD + 1024 + (i & 15)]);
    for (int i = tid; i < 16 * 128; i += 256) w2_s[i] = wg2[(i >> 7) * 512 + h * 128 + (i & 127)];
    __syncthreads();
    {
      const int kk = tid & 127, ih = tid >> 7;
      const float bg = bgate[h * 128 + kk];
      float wc[16];
#pragma unroll
      for (int r = 0; r < 16; ++r) wc[r] = w2_s[r * 128 + kk];
      for (int i = ih * 32; i < ih * 32 + 32; ++i) {
        float z = bg;
#pragma unroll
        for (int r = 0; r < 16; ++r) z += glr_s[i * 16 + r] * wc[r];
        const float ls = fminf(z, 0.f) - log1pf(__expf(-fabsf(z)));
        b_s[i * BSTR + kk] = ls * (1.f / 16.f);
      }
    }
    __syncthreads();
    if (tid < 128) {
      float run = 0.f;
      for (int i = 0; i < 64; ++i) { run += b_s[i * BSTR + tid]; b_s[i * BSTR + tid] = run; }
    }
    __syncthreads();
    {
      const int i = tid >> 2, k0 = (tid & 3) * 32;
      u16* qg = proj + (T0 + i) * GLA_LD + h * 128 + k0;
      const u16* kg = proj + (T0 + i) * GLA_LD + 512 + h * 128 + k0;
      const float qscale = 0.08838834764831845f;
#pragma unroll
      for (int cc = 0; cc < 4; ++cc) {
        uint4 qv = *(const uint4*)(qg + cc * 8);
        uint4 kv = *(const uint4*)(kg + cc * 8);
        u32 qw[4] = {qv.x, qv.y, qv.z, qv.w};
        u32 kw[4] = {kv.x, kv.y, kv.z, kv.w};
        u32 qo[4], ko[4];
#pragma unroll
        for (int j = 0; j < 4; ++j) {
          const int kk = k0 + cc * 8 + 2 * j;
          const float b0 = b_s[i * BSTR + kk], b1 = b_s[i * BSTR + kk + 1];
          qo[j] = pk2(bflo(qw[j]) * qscale * __expf(b0), bfhi(qw[j]) * qscale * __expf(b1));
          ko[j] = pk2(bflo(kw[j]) * __expf(-b0), bfhi(kw[j]) * __expf(-b1));
        }
        *(uint4*)(qe_s + i * GQSTR + (k0 + cc * 8) * 2) = make_uint4(qo[0], qo[1], qo[2], qo[3]);
        *(uint4*)(ke_s + i * GQSTR + (k0 + cc * 8) * 2) = make_uint4(ko[0], ko[1], ko[2], ko[3]);
        *(uint4*)(qg + cc * 8) = make_uint4(qo[0], qo[1], qo[2], qo[3]);
      }
      if (tid < 128) gd[(size_t)item * 128 + tid] = __expf(b_s[63 * BSTR + tid]);
    }
    {
      const int k = tid >> 1, j0 = (tid & 1) * 32;
      u16* kp = ktg + (size_t)(h * 128 + k) * MTOK + T0 + j0;
      const float bl = b_s[63 * BSTR + k];
#pragma unroll
      for (int cc = 0; cc < 4; ++cc) {
        uint4 kv = *(const uint4*)(kp + cc * 8);
        u32 kw[4] = {kv.x, kv.y, kv.z, kv.w};
        u32 ko[4];
#pragma unroll
        for (int j = 0; j < 4; ++j) {
          const int jj = j0 + cc * 8 + 2 * j;
          ko[j] = pk2(bflo(kw[j]) * __expf(bl - b_s[jj * BSTR + k]), bfhi(kw[j]) * __expf(bl - b_s[(jj + 1) * BSTR + k]));
        }
        *(uint4*)(kp + cc * 8) = make_uint4(ko[0], ko[1], ko[2], ko[3]);
      }
    }
    __syncthreads();
    {
      f32x4 acc[4];
#pragma unroll
      for (int jt = 0; jt < 4; ++jt) acc[jt] = f32x4{0.f, 0.f, 0.f, 0.f};
#pragma unroll
      for (int ks = 0; ks < 4; ++ks) {
        bf16x8 qfr = *(const bf16x8*)(qe_s + (wave * 16 + l15) * GQSTR + ks * 64 + q4 * 16);
#pragma unroll
        for (int jt = 0; jt < 4; ++jt) {
          bf16x8 kfr = *(const bf16x8*)(ke_s + (jt * 16 + l15) * GQSTR + ks * 64 + q4 * 16);
          acc[jt] = MFMA16(kfr, qfr, acc[jt]);
        }
      }
      const int i = wave * 16 + l15;
#pragma unroll
      for (int jt = 0; jt < 4; ++jt) {
        const int j0 = jt * 16 + q4 * 4;
        const float v0 = (j0 + 0 <= i) ? acc[jt][0] : 0.f;
        const float v1 = (j0 + 1 <= i) ? acc[jt][1] : 0.f;
        const float v2 = (j0 + 2 <= i) ? acc[jt][2] : 0.f;
        const float v3 = (j0 + 3 <= i) ? acc[jt][3] : 0.f;
        *(uint2*)(attb + ((size_t)item * 64 + i) * 64 + j0) = make_uint2(pk2(v0, v1), pk2(v2, v3));
      }
    }
  }
}

DEV void phase_gla_g2(const Params& p, char* smem) {
  const u16* proj = (const u16*)(p.ws + OFF_BIG);
  const u16* vtg = (const u16*)(p.ws + OFF_BIG + BIG_GVT);
  const u16* ktg = (const u16*)(p.ws + OFF_KT);
  const u16* attb = (const u16*)(p.ws + OFF_ATT);
  const float* gd = (const float*)(p.ws + OFF_GD);
  u16* ao = (u16*)(p.ws + OFF_AO);
  char* att_s = smem;
  char* q_s = smem + 9216;
  char* vT_s = q_s + 17408;
  char* kT_s = vT_s + 4608;
  char* sT_s = kT_s + 18432;
  const int tid = otid(), lane = tid & 63, wave = tid >> 6, l15 = lane & 15, q4 = lane >> 4;
  for (int item = blockIdx.x; item < 512; item += gridDim.x) {
    const int vs = item & 7, h = (item >> 3) & 3, b = item >> 5;
    f32x4 S[2][2];
#pragma unroll
    for (int vt = 0; vt < 2; ++vt)
#pragma unroll
      for (int kk = 0; kk < 2; ++kk) S[vt][kk] = f32x4{0.f, 0.f, 0.f, 0.f};
    uint4 ra0, ra1, rq0, rq1, rq2, rq3, rv, rk0, rk1, rk2, rk3;
    float dk0, dk1;
#define G2_LQ(i_) { const int idx_ = tid + 256 * (i_);                                                          \
      rq##i_ = *(const uint4*)(proj + (T0_ + (idx_ >> 4)) * GLA_LD + h * 128 + (idx_ & 15) * 8);                 \
      rk##i_ = *(const uint4*)(ktg + (size_t)(h * 128 + (idx_ >> 3)) * MTOK + T0_ + (idx_ & 7) * 8); }
#define G2_LOAD(c_)                                                                                              \
  {                                                                                                              \
    const size_t T0_ = (size_t)b * SEQL + (c_) * 64;                                                             \
    const size_t ci_ = (size_t)((b * 4 + h) * 32 + (c_));                                                        \
    ra0 = *(const uint4*)(attb + ci_ * 4096 + (size_t)(tid) * 8);                                              \
    ra1 = *(const uint4*)(attb + ci_ * 4096 + (size_t)(tid + 256) * 8);                                        \
    G2_LQ(0) G2_LQ(1) G2_LQ(2) G2_LQ(3)                                                                          \
    rv = *(const uint4*)(vtg + (size_t)(h * 256 + vs * 32 + (tid >> 3)) * MTOK + T0_ + (tid & 7) * 8);           \
    dk0 = gd[ci_ * 128 + (2 * wave) * 16 + l15];                                                                \
    dk1 = gd[ci_ * 128 + (2 * wave + 1) * 16 + l15];                                                            \
  }
    G2_LOAD(0);
    for (int c = 0; c < 32; ++c) {
      const size_t T0 = (size_t)b * SEQL + c * 64;
      __syncthreads();
#define G2_ST(i_) { const int idx = tid + 256 * (i_);                                       \
        *(uint4*)(q_s + (idx >> 4) * GQSTR + (idx & 15) * 16) = rq##i_;                     \
        *(uint4*)(kT_s + (idx >> 3) * 144 + (idx & 7) * 16) = rk##i_; }
      *(uint4*)(att_s + (tid >> 3) * 144 + (tid & 7) * 16) = ra0;
      *(uint4*)(att_s + ((tid + 256) >> 3) * 144 + (tid & 7) * 16) = ra1;
      G2_ST(0) G2_ST(1) G2_ST(2) G2_ST(3)
#undef G2_ST
      *(uint4*)(vT_s + (tid >> 3) * 144 + (tid & 7) * 16) = rv;
#pragma unroll
      for (int vt = 0; vt < 2; ++vt)
#pragma unroll
        for (int kk = 0; kk < 2; ++kk)
#pragma unroll
          for (int jj = 0; jj < 4; ++jj)
            *(u16*)(sT_s + (vt * 16 + q4 * 4 + jj) * GQSTR + ((2 * wave + kk) * 16 + l15) * 2) = f2bf(S[vt][kk][jj]);
      const float d0 = dk0, d1 = dk1;
      __syncthreads();
      if (c + 1 < 32) G2_LOAD(c + 1);
      f32x4 o[2];
      o[0] = f32x4{0.f, 0.f, 0.f, 0.f}; o[1] = o[0];
#pragma unroll
      for (int ks = 0; ks < 2; ++ks) {
        bf16x8 bfr = *(const bf16x8*)(att_s + (wave * 16 + l15) * 144 + ks * 64 + q4 * 16);
#pragma unroll
        for (int vt = 0; vt < 2; ++vt) {
          bf16x8 afr = *(const bf16x8*)(vT_s + (vt * 16 + l15) * 144 + ks * 64 + q4 * 16);
          o[vt] = MFMA16(afr, bfr, o[vt]);
        }
      }
#pragma unroll
      for (int ks = 0; ks < 4; ++ks) {
        bf16x8 bfr = *(const bf16x8*)(q_s + (wave * 16 + l15) * GQSTR + ks * 64 + q4 * 16);
#pragma unroll
        for (int vt = 0; vt < 2; ++vt) {
          bf16x8 afr = *(const bf16x8*)(sT_s + (vt * 16 + l15) * GQSTR + ks * 64 + q4 * 16);
          o[vt] = MFMA16(afr, bfr, o[vt]);
        }
      }
#pragma unroll
      for (int vt = 0; vt < 2; ++vt)
        *(uint2*)(ao + kb32(T0 + wave * 16 + l15, h * 256 + vs * 32 + vt * 16 + q4 * 4, MTOK)) =
            make_uint2(pk2(o[vt][0], o[vt][1]), pk2(o[vt][2], o[vt][3]));
#pragma unroll
      for (int vt = 0; vt < 2; ++vt) {
        S[vt][0][0] *= d0; S[vt][0][1] *= d0; S[vt][0][2] *= d0; S[vt][0][3] *= d0;
        S[vt][1][0] *= d1; S[vt][1][1] *= d1; S[vt][1][2] *= d1; S[vt][1][3] *= d1;
      }
#pragma unroll
      for (int ks = 0; ks < 2; ++ks) {
        bf16x8 afr[2];
#pragma unroll
        for (int vt = 0; vt < 2; ++vt) afr[vt] = *(const bf16x8*)(vT_s + (vt * 16 + l15) * 144 + ks * 64 + q4 * 16);
#pragma unroll
        for (int kk = 0; kk < 2; ++kk) {
          bf16x8 bfr = *(const bf16x8*)(kT_s + ((2 * wave + kk) * 16 + l15) * 144 + ks * 64 + q4 * 16);
#pragma unroll
          for (int vt = 0; vt < 2; ++vt) S[vt][kk] = MFMA16(afr[vt], bfr, S[vt][kk]);
        }
      }
    }
#undef G2_LOAD
#undef G2_LQ
  }
}

DEV void phase_gla_g3(const Params& p) {
  const u16* proj = (const u16*)(p.ws + OFF_BIG);
  u16* ao = (u16*)(p.ws + OFF_AO);
  const float* ng = p.in[24];
  const int wave = otid() >> 6, lane = otid() & 63;
  for (int th = blockIdx.x * 4 + wave; th < MTOK * 4; th += gridDim.x * 4) {
    const size_t tok = th >> 2; const int h = th & 3;
    u16* op = ao + kb32(tok, h * 256 + lane * 4, MTOK);
    uint2 v = *(const uint2*)op;
    float x0 = bflo(v.x), x1 = bfhi(v.x), x2 = bflo(v.y), x3 = bfhi(v.y);
    float ss = x0 * x0 + x1 * x1 + x2 * x2 + x3 * x3;
#pragma unroll
    for (int o = 32; o > 0; o >>= 1) ss += __shfl_xor(ss, o);
    const float rs = rsqrtf(ss * (1.f / 256.f) + 1e-5f);
    uint2 rv = *(const uint2*)(proj + tok * GLA_LD + 1040 + h * 256 + lane * 4);
    float4 gg = *(const float4*)(ng + lane * 4);
    float r0 = bflo(rv.x), r1 = bfhi(rv.x), r2 = bflo(rv.y), r3 = bfhi(rv.y);
    float y0 = x0 * rs * gg.x * (r0 / (1.f + __expf(-r0)));
    float y1 = x1 * rs * gg.y * (r1 / (1.f + __expf(-r1)));
    float y2 = x2 * rs * gg.z * (r2 / (1.f + __expf(-r2)));
    float y3 = x3 * rs * gg.w * (r3 / (1.f + __expf(-r3)));
    *(uint2*)op = make_uint2(pk2(y0, y1), pk2(y2, y3));
  }
}

DEV void phase_pool_diff(const Params& p) {
  u16* ao = (u16*)(p.ws + OFF_AO);
  const size_t nitems = (size_t)(MTOK / 16) * 256;
  for (size_t i = (size_t)blockIdx.x * NTHREADS + otid(); i < nitems; i += (size_t)gridDim.x * NTHREADS) {
    const int c = (int)(i & 255) * 4;
    const size_t tok0 = (i >> 8) * 16;
    const int t0 = (int)(tok0 & (SEQL - 1));
    const int w = 2 << (c >> 8);
    const float* xp = p.xf + tok0 * 1024 + c;
    float4 s = make_float4(0.f, 0.f, 0.f, 0.f);
    for (int j = w - 1; j >= 1; --j) {
      if (t0 - j >= 0) {
        float4 v = *(const float4*)(xp - (size_t)j * 1024);
        s.x += v.x; s.y += v.y; s.z += v.z; s.w += v.w;
      }
    }
    for (int k = 0; k < 16; ++k) {
      const int t = t0 + k;
      float4 x0 = *(const float4*)(xp + (size_t)k * 1024);
      s.x += x0.x; s.y += x0.y; s.z += x0.z; s.w += x0.w;
      const int cntw = (t + 1 < w) ? (t + 1) : w;
      const float inv = 1.f / (float)cntw;
      *(uint2*)(ao + kb32(tok0 + k, c, MTOK)) =
          make_uint2(pk2(s.x * inv - x0.x, s.y * inv - x0.y), pk2(s.z * inv - x0.z, s.w * inv - x0.w));
      if (t - (w - 1) >= 0) {
        float4 v = *(const float4*)(xp + (size_t)(k - (w - 1)) * 1024);
        s.x -= v.x; s.y -= v.y; s.z -= v.z; s.w -= v.w;
      }
    }
  }
}

__global__ void __launch_bounds__(NTHREADS, 2) fwd_megakernel(Params p, int ph_lo, int ph_hi) {
  extern __shared__ __attribute__((aligned(16))) char smem[];
  cg::grid_group grid = cg::this_grid();
  int ph = 0;
  volatile unsigned* bst = (volatile unsigned*)(smem + SMEM_BYTES - 16);
  if (threadIdx.x == 0) { bst[0] = 0u; bst[1] = 0u; }
  __syncthreads();
  XcdBarrier gbar = xcd_barrier_post((unsigned*)(p.ws + OFF_BAR), bst);
  u16* wt = (u16*)(p.ws + OFF_WT);
  u16* xb = (u16*)(p.ws + OFF_XB);
  u16* big = (u16*)(p.ws + OFF_BIG);
  u16* ao = (u16*)(p.ws + OFF_AO);
  unsigned long long* lnslots = (unsigned long long*)(p.ws + OFF_LNX);
  unsigned* lnflags = (unsigned*)(p.ws + OFF_LNF);
#define PHASE(...)                                    \
  {                                                   \
    if (ph >= ph_lo && ph < ph_hi) {                  \
      if (ph > ph_lo) xcd_barrier(gbar);              \
      __VA_ARGS__;                                    \
    }                                                 \
    ++ph;                                             \
  }
  PHASE({ phase_init(p); phase_conv_weights(p, 0, smem); });
  for (int L = 0; L < 4; ++L) {
    const float* lng = p.in[2] + (size_t)L * 4096;
    const float* lnb = p.in[3] + (size_t)L * 4096;
    PHASE({ int base = 0; EpiArgs ea{big, FF, 1.f, nullptr};
            gemm_job<1>(base, wt + W_GU1, 5632, 22, xb, MTOK, 256, 1024, false, ea, smem); });
    PHASE({ int base = 0;
            EpiArgs ea{nullptr, 0, 0.5f, nullptr, L == 0 ? p.in[0] : p.xf, p.xf, xb, lng, lnb, lnslots, lnflags + (L * 4 + 0) * 256};
            gemm_job<4>(base, wt + W_D1, 1024, 4, big, MTOK, 256, FF, false, ea, smem); });
    if (L == 0) {
      PHASE({ int base = 0;
              EpiArgs ea{big, 1280, 1.f, nullptr};
              gemm_job<0>(base, wt + W_MIN, 1536, 5, xb, MTOK, 256, 1024, false, ea, smem);
              EpiArgs eb{(char*)big + BIG_VT2, MTOK, 1.f, nullptr};
              gemm_job<0>(base, xb, MTOK, 128, wt + W_MIN + 1280ull * 32, 1536, 2, 1024, true, eb, smem); });
      PHASE(phase_swa_attn(p, smem));
    } else if (L == 1) {
      PHASE({ int base = 0;
              EpiArgs ea{big, NSA_LD, 1.f, nullptr};
              gemm_job<0>(base, wt + W_MIN, 2048, 7, xb, MTOK, 256, 1024, false, ea, smem);
              EpiArgs eb{(char*)big + BIG_VT2, MTOK, 1.f, nullptr};
              gemm_job<0>(base, xb, MTOK, 128, wt + W_MIN + 1792ull * 32, 2048, 2, 1024, true, eb, smem); });
      PHASE(phase_nsa_compress(p, smem));
      PHASE(phase_nsa_attn(p, smem));
    } else if (L == 2) {
      PHASE({ int base = 0; EpiArgs ea{big, GLA_LD, 1.f, nullptr};
              gemm_job<0>(base, wt + W_MIN, 3328, 9, xb, MTOK, 256, 1024, false, ea, smem);
              EpiArgs ev{(char*)big + BIG_GVT, MTOK, 1.f, nullptr};
              gemm_job<0>(base, xb, MTOK, 128, wt + W_MIN + 2304ull * 32, 3328, 8, 1024, true, ev, smem);
              EpiArgs ek{p.ws + OFF_KT, MTOK, 1.f, nullptr};
              gemm_job<0>(base, xb, MTOK, 128, wt + W_MIN + 512ull * 32, 3328, 4, 1024, true, ek, smem); });
      PHASE(phase_gla_g1(p, smem));
      PHASE(phase_gla_g2(p, smem));
      PHASE(phase_gla_g3(p));
    } else {
      PHASE(phase_pool_diff(p));
    }
    if (L < 3) {
      PHASE({ int base = 0;
              EpiArgs ea{nullptr, 0, 1.f, nullptr, p.xf, p.xf, xb, lng + 1024, lnb + 1024, lnslots, lnflags + (L * 4 + 1) * 256};
              gemm_job<4>(base, wt + W_MOUT, 1024, 4, ao, MTOK, 256, 1024, false, ea, smem); });
    } else {
      PHASE({ int base = 0;
              EpiArgs ea{nullptr, 0, 1.f, nullptr, p.xf, p.xf, xb, lng + 1024, lnb + 1024, lnslots, lnflags + (L * 4 + 1) * 256};
              gemm_job<4>(base, wt + W_MIN, 1024, 4, ao, MTOK, 256, 256, false, ea, smem, (size_t)8 * MTOK * 32); });
    }
    PHASE({ int base = 0;
            EpiArgs ea{big, 1024, 1.f, nullptr};
            gemm_job<0>(base, wt + W_XQ, 1024, 4, xb, MTOK, 256, 1024, false, ea, smem);
            EpiArgs ek{p.ws + OFF_KB, 1024, 1.f, nullptr};
            gemm_job<0>(base, wt + W_XKV, 2048, 4, (const u16*)(p.ws + OFF_MEMB), 4096, 32, 1024, false, ek, smem);
            EpiArgs ev{p.ws + OFF_VT, 4096, 1.f, nullptr};
            gemm_job<0>(base, (const u16*)(p.ws + OFF_MEMB), 4096, 16, wt + W_XKV + 1024ull * 32, 2048, 8, 1024, true, ev, smem); });
    PHASE(phase_xattn(p, smem));
    PHASE({ int base = 0;
            EpiArgs ea{nullptr, 0, 1.f, nullptr, p.xf, p.xf, xb, lng + 2048, lnb + 2048, lnslots, lnflags + (L * 4 + 2) * 256};
            gemm_job<4>(base, wt + W_XO, 1024, 4, ao, MTOK, 256, 1024, false, ea, smem); });
    PHASE({ int base = 0; EpiArgs ea{big, FF, 1.f, nullptr};
            gemm_job<1>(base, wt + W_GU2, 5632, 22, xb, MTOK, 256, 1024, false, ea, smem); });
    PHASE({ int base = 0;
            EpiArgs ea{nullptr, 0, 0.5f, nullptr, p.xf, p.xf, L == 3 ? nullptr : xb, lng + 3072, lnb + 3072, lnslots, lnflags + (L * 4 + 3) * 256};
            gemm_job<4>(base, wt + W_D2, 1024, 4, big, MTOK, 256, FF, false, ea, smem); });
    if (L < 3) PHASE(phase_conv_weights(p, L + 1, smem));
  }
  if (ph_hi == -12345) grid.sync();
#undef PHASE
}

constexpr int N_PHASES = 1 << 20;

#ifndef MULTI_LAUNCH
#define MULTI_LAUNCH 0
#endif

extern "C" void kernel_launch(void* const* d_in, const int* in_sizes, int n_in, void* d_out, int out_size, void* d_ws,
                              size_t ws_size, hipStream_t stream) {
  static int grid_blocks = 0;
  if (!grid_blocks) {
    hipFuncSetAttribute((const void*)fwd_megakernel, hipFuncAttributeMaxDynamicSharedMemorySize, SMEM_BYTES);
    int dev = 0, cus = 0, per_cu = 0;
    hipGetDevice(&dev);
    hipDeviceGetAttribute(&cus, hipDeviceAttributeMultiprocessorCount, dev);
    hipOccupancyMaxActiveBlocksPerMultiprocessor(&per_cu, fwd_megakernel, NTHREADS, SMEM_BYTES);
    if (per_cu > 2) per_cu = 2;
    if (per_cu < 1) per_cu = 1;
    grid_blocks = cus * per_cu;
  }
  Params p{};
  for (int i = 0; i < 28; ++i) p.in[i] = (const float*)d_in[i];
  p.xf = (float*)d_out;
  p.ws = (char*)d_ws;
#if MULTI_LAUNCH
  for (int ph = 0; ph < N_PHASES; ++ph) {
    hipLaunchKernelGGL(fwd_megakernel, dim3(grid_blocks), dim3(NTHREADS), SMEM_BYTES, stream, p, ph, ph + 1);
  }
#else
  hipMemsetAsync((char*)d_ws + OFF_BAR, 0, 32768, stream);
  int lo = 0, hi = N_PHASES;
  void* args[] = {&p, &lo, &hi};
  hipError_t e = hipLaunchCooperativeKernel((const void*)fwd_megakernel, dim3(grid_blocks), dim3(NTHREADS), args,
                                            SMEM_BYTES, stream);
  if (e != hipSuccess) fprintf(stderr, "cooperative launch failed: %s (grid %d)\n", hipGetErrorString(e), grid_blocks);
#endif
}
```

```cpp
#include <hip/hip_runtime.h>
#include <hip/hip_cooperative_groups.h>
#include <cstdio>
namespace cg = cooperative_groups;

typedef unsigned short u16;
typedef unsigned int u32;
using bf16x8 = __attribute__((ext_vector_type(8))) short;
using f32x4 = __attribute__((ext_vector_type(4))) float;
typedef float f32x2_t __attribute__((ext_vector_type(2)));
typedef __bf16 bf16x2_t __attribute__((ext_vector_type(2)));
#define DEV __device__ __forceinline__
#define MFMA16(a, b, c) __builtin_amdgcn_mfma_f32_16x16x32_bf16((a), (b), (c), 0, 0, 0)

constexpr int MTOK = 32768;
constexpr int SEQL = 2048;
constexpr int FF = 2816;
constexpr float ALPHA = 1.6817928305074290f;
constexpr float NEGBIG = -1e30f;
constexpr float LOG2E = 1.4426950408889634f;
constexpr int NTHREADS = 256;
constexpr int SMEM_BYTES = 80896;

constexpr size_t MiB = 1ull << 20;
constexpr size_t OFF_XB = 0;
constexpr size_t OFF_BIG = 64 * MiB;
constexpr size_t OFF_AO = 272 * MiB;
constexpr size_t OFF_WT = 336 * MiB;
constexpr size_t OFF_MEMB = 388 * MiB;
constexpr size_t OFF_KB = 396 * MiB;
constexpr size_t OFF_VT = 404 * MiB;
constexpr size_t OFF_ATT = 412 * MiB;
constexpr size_t OFF_CMP = 444 * MiB;
constexpr size_t OFF_SEL = 448 * MiB;
constexpr size_t OFF_GD = 449 * MiB;
constexpr size_t OFF_BAR = 451 * MiB;
constexpr size_t OFF_LNX = 484 * MiB;
constexpr size_t OFF_LNF = OFF_BAR + 16384;
constexpr size_t OFF_KT = 452 * MiB;
constexpr size_t BIG_GVT = 144 * MiB;
constexpr size_t BIG_VT2 = 112 * MiB;
constexpr size_t BIG_OC = 128 * MiB;
constexpr size_t W_GU1 = 0;
constexpr size_t W_D1 = W_GU1 + 5632ull * 1024;
constexpr size_t W_GU2 = W_D1 + 1024ull * 2816;
constexpr size_t W_D2 = W_GU2 + 5632ull * 1024;
constexpr size_t W_XQ = W_D2 + 1024ull * 2816;
constexpr size_t W_XKV = W_XQ + 1024ull * 1024;
constexpr size_t W_XO = W_XKV + 2048ull * 1024;
constexpr size_t W_MIN = W_XO + 1024ull * 1024;
constexpr size_t W_MOUT = W_MIN + 3328ull * 1024;

struct Params {
  const float* in[28];
  float* xf;
  char* ws;
};

DEV int otid() { int t = threadIdx.x; asm volatile("" : "+v"(t)); return t; }
DEV size_t kb32(size_t row, int col, size_t R) { return ((size_t)(col >> 5) * R + row) * 32 + (col & 31); }
DEV float bf2f(u16 h) { return __uint_as_float(((u32)h) << 16); }
DEV u32 pk2(float a, float b) {
  f32x2_t v = {a, b};
  bf16x2_t r = __builtin_convertvector(v, bf16x2_t);
  return __builtin_bit_cast(u32, r);
}
DEV u16 f2bf(float a) { return (u16)(pk2(a, 0.f) & 0xffffu); }
DEV float bflo(u32 w) { return __uint_as_float(w << 16); }
DEV float bfhi(u32 w) { return __uint_as_float(w & 0xffff0000u); }


#define XB_TMO      128
#define XB_XCNT(j)  (256  + 64 * (j))
#define XB_XSUB(j)  (1280 + 64 * (j))
#define XB_XGEN(j)  (2304 + 64 * (j))
#define XB_TOP      3328
#define XB_TOPGEN   3392
#define XCD_BAR_WORDS 3456
#define XB_SPIN_CAP (1u << 22)
#define LAS __attribute__((address_space(3)))
DEV unsigned xb_ld(unsigned* p) { return __hip_atomic_load(p, __ATOMIC_RELAXED, __HIP_MEMORY_SCOPE_AGENT); }
DEV unsigned xb_add(unsigned* p, unsigned v) { return __hip_atomic_fetch_add(p, v, __ATOMIC_RELAXED, __HIP_MEMORY_SCOPE_AGENT); }
DEV unsigned xb_xcc_id() { return (unsigned)__builtin_amdgcn_s_getreg((3 << 11) | 20) & 0xFu; }
#define XB_SPIN(cond, bar) do { unsigned _sp = 0; while (cond) { __builtin_amdgcn_s_sleep(1); \
    if ((++_sp & 255u) == 0u) { if (xb_ld(&(bar)[XB_TMO])) break; if (_sp > XB_SPIN_CAP) { atomicAdd(&(bar)[XB_TMO], 1u); break; } } } } while (0)
struct XcdBarrier { unsigned* bar; unsigned x; volatile unsigned* st; };
DEV XcdBarrier xcd_barrier_post(unsigned* bar, volatile unsigned* st) {
  XcdBarrier b; b.bar = bar; b.x = xb_xcc_id(); b.st = st;
  if (threadIdx.x == 0) (void)xb_add(&bar[XB_XCNT(b.x)], 1u);
  return b;
}
DEV void xcd_barrier_complete(unsigned* bar, unsigned x, unsigned& nloc, unsigned& nx) {
  const unsigned G = gridDim.x * gridDim.y * gridDim.z;
  unsigned sum, cnt, mine, sp = 0u;
  for (;;) {
    sum = 0u; cnt = 0u; mine = 0u;
#pragma unroll
    for (unsigned j = 0; j < 16; ++j) { const unsigned c = xb_ld(&bar[XB_XCNT(j)]); sum += c; cnt += (c > 0u) ? 1u : 0u; mine = (j == x) ? c : mine; }
    if (sum == G) break;
    __builtin_amdgcn_s_sleep(1);
    if ((++sp & 255u) == 0u) { if (xb_ld(&bar[XB_TMO])) break; if (sp > XB_SPIN_CAP) { atomicAdd(&bar[XB_TMO], 1u); break; } }
  }
  nloc = mine > 0u ? mine : 1u; nx = cnt > 0u ? cnt : 1u;
}
DEV void xcd_barrier(const XcdBarrier& b) {
  asm volatile("s_waitcnt vmcnt(0)" ::: "memory");
  __syncthreads();
  if (threadIdx.x == 0) {
    unsigned* bar = b.bar;
    __builtin_amdgcn_s_waitcnt(0);
    unsigned nloc = b.st[0], nx = b.st[1];
    if (nloc == 0u) { xcd_barrier_complete(bar, b.x, nloc, nx); b.st[0] = nloc; b.st[1] = nx; }
    const unsigned old = xb_add(&bar[XB_XSUB(b.x)], 1u);
    const unsigned gen = old / nloc;
    if (old + 1u == (gen + 1u) * nloc) {
      __builtin_amdgcn_fence(__ATOMIC_RELEASE, "agent");
      asm volatile("s_waitcnt vmcnt(0)" ::: "memory");
      const unsigned og = xb_add(&bar[XB_TOP], 1u);
      const unsigned tg = og / nx;
      if (og + 1u == (tg + 1u) * nx) xb_add(&bar[XB_TOPGEN], 1u);
      else XB_SPIN(xb_ld(&bar[XB_TOPGEN]) == tg, bar);
      __builtin_amdgcn_fence(__ATOMIC_ACQUIRE, "agent");
      xb_add(&bar[XB_XGEN(b.x)], 1u);
      asm volatile("s_waitcnt vmcnt(0)" ::: "memory");
    } else {
      XB_SPIN(xb_ld(&bar[XB_XGEN(b.x)]) == gen, bar);
      __builtin_amdgcn_fence(__ATOMIC_ACQUIRE, "agent");
      asm volatile("s_waitcnt vmcnt(0)" ::: "memory");
    }
  }
  __syncthreads();
}

DEV void phase_init(const Params& p) {
  const float4* x4 = (const float4*)p.in[0];
  uint2* xb2 = (uint2*)(p.ws + OFF_XB);
  const size_t n4 = (size_t)MTOK * 1024 / 4;
  for (size_t i = (size_t)blockIdx.x * NTHREADS + otid(); i < n4; i += (size_t)gridDim.x * NTHREADS) {
    float4 v = x4[i];
    *(uint2*)((u16*)xb2 + kb32(i >> 8, (int)(i & 255) * 4, MTOK)) = make_uint2(pk2(v.x, v.y), pk2(v.z, v.w));
  }
  const float4* m4 = (const float4*)p.in[1];
  uint2* mb2 = (uint2*)(p.ws + OFF_MEMB);
  const size_t nm4 = (size_t)4096 * 1024 / 4;
  for (size_t i = (size_t)blockIdx.x * NTHREADS + otid(); i < nm4; i += (size_t)gridDim.x * NTHREADS) {
    float4 v = m4[i];
    *(uint2*)((u16*)mb2 + kb32(i >> 8, (int)(i & 255) * 4, 4096)) = make_uint2(pk2(v.x, v.y), pk2(v.z, v.w));
  }
}

DEV void conv_job(int& base, const float* src, const float* src2, int mode, int lds, int s0, int cnt, int cntpad,
                  int K, u16* dst, int d0, float scale, char* smem, int Rtot, const float* rowscale = nullptr) {
  float* t = (float*)smem;
  const int nrt = cntpad >> 6, nkt = K >> 6, nt = nrt * nkt;
  const int G = gridDim.x;
  int first = ((int)blockIdx.x - (base % G) + G) % G;
  const int tid = otid();
  for (int tile = first; tile < nt; tile += G) {
    const int r0 = (tile % nrt) << 6, k0 = (tile / nrt) << 6;
#pragma unroll 4
    for (int i = 0; i < 16; ++i) {
      int idx = tid + 256 * i;
      int kk = idx >> 6, r = idx & 63;
      int n = r0 + r;
      float v = 0.f;
      if (n < cnt) {
        const float* sp = src;
        int col = s0 + n;
        if (mode) { sp = ((n >> 4) & 1) ? src2 : src; col = ((n >> 5) << 4) + (n & 15); }
        v = sp[(size_t)(k0 + kk) * lds + col] * scale;
        if (rowscale) v *= rowscale[n];
      }
      t[kk * 65 + r] = v;
    }
    __syncthreads();
    {
      int r = tid >> 2, kc = (tid & 3) << 4;
      u32 w[8];
#pragma unroll
      for (int j = 0; j < 8; ++j) w[j] = pk2(t[(kc + 2 * j) * 65 + r], t[(kc + 2 * j + 1) * 65 + r]);
      uint4* dp = (uint4*)(dst + kb32(d0 + r0 + r, k0 + kc, Rtot));
      dp[0] = make_uint4(w[0], w[1], w[2], w[3]);
      dp[1] = make_uint4(w[4], w[5], w[6], w[7]);
    }
    __syncthreads();
  }
  base += nt;
}

DEV void phase_conv_weights(const Params& p, int L, char* smem) {
  u16* wt = (u16*)(p.ws + OFF_WT);
  int base = 0;
  const size_t fo = (size_t)L * 1024 * FF;
  conv_job(base, p.in[4] + fo, p.in[5] + fo, 1, FF, 0, 5632, 5632, 1024, wt + W_GU1, 0, 1.f, smem, 5632);
  conv_job(base, p.in[6] + fo, nullptr, 0, 1024, 0, 1024, 1024, FF, wt + W_D1, 0, 1.f, smem, 1024);
  conv_job(base, p.in[7] + fo, p.in[8] + fo, 1, FF, 0, 5632, 5632, 1024, wt + W_GU2, 0, 1.f, smem, 5632);
  conv_job(base, p.in[9] + fo, nullptr, 0, 1024, 0, 1024, 1024, FF, wt + W_D2, 0, 1.f, smem, 1024);
  conv_job(base, p.in[10] + (size_t)L * 1024 * 1024, nullptr, 0, 1024, 0, 1024, 1024, 1024, wt + W_XQ, 0, 0.0625f * LOG2E, smem, 1024);
  conv_job(base, p.in[11] + (size_t)L * 1024 * 2048, nullptr, 0, 2048, 0, 2048, 2048, 1024, wt + W_XKV, 0, 1.f, smem, 2048);
  conv_job(base, p.in[12] + (size_t)L * 1024 * 1024, nullptr, 0, 1024, 0, 1024, 1024, 1024, wt + W_XO, 0, 1.f, smem, 1024);
  if (L == 0) {
    conv_job(base, p.in[13], nullptr, 0, 1536, 0, 1024, 1024, 1024, wt + W_MIN, 0, 0.125f * LOG2E, smem, 1536);
    conv_job(base, p.in[13], nullptr, 0, 1536, 1024, 512, 512, 1024, wt + W_MIN, 1024, 1.f, smem, 1536);
    conv_job(base, p.in[15], nullptr, 0, 1024, 0, 1024, 1024, 1024, wt + W_MOUT, 0, 1.f, smem, 1024);
  } else if (L == 1) {
    conv_job(base, p.in[16], nullptr, 0, 1840, 0, 1024, 1024, 1024, wt + W_MIN, 0, 0.125f * LOG2E, smem, 2048);
    conv_job(base, p.in[16], nullptr, 0, 1840, 1024, 384, 384, 1024, wt + W_MIN, 1024, 1.f, smem, 2048);
    conv_job(base, p.in[16], nullptr, 0, 1840, 1536, 128, 128, 1024, wt + W_MIN, 1408, 1.f, smem, 2048);
    conv_job(base, p.in[16], nullptr, 0, 1840, 1792, 48, 256, 1024, wt + W_MIN, 1536, 1.f, smem, 2048);
    conv_job(base, p.in[16], nullptr, 0, 1840, 1408, 128, 128, 1024, wt + W_MIN, 1792, 1.f, smem, 2048);
    conv_job(base, p.in[16], nullptr, 0, 1840, 1664, 128, 128, 1024, wt + W_MIN, 1920, 1.f, smem, 2048);
    conv_job(base, p.in[20], nullptr, 0, 1024, 0, 1024, 1024, 1024, wt + W_MOUT, 0, 1.f, smem, 1024);
  } else if (L == 2) {
    conv_job(base, p.in[21], nullptr, 0, 3088, 0, 1024, 1024, 1024, wt + W_MIN, 0, 1.f, smem, 3328);
    conv_job(base, p.in[21], nullptr, 0, 3088, 2048, 1040, 1280, 1024, wt + W_MIN, 1024, 1.f, smem, 3328);
    conv_job(base, p.in[21], nullptr, 0, 3088, 1024, 1024, 1024, 1024, wt + W_MIN, 2304, 1.f, smem, 3328);
    conv_job(base, p.in[25], nullptr, 0, 1024, 0, 1024, 1024, 1024, wt + W_MOUT, 0, 1.f, smem, 1024);
  } else {
    for (int g = 0; g < 4; ++g)
      conv_job(base, p.in[26] + (size_t)g * 65536, nullptr, 0, 256, 0, 256, 256, 256, wt + W_MIN, g * 256, 1.f, smem, 1024, p.in[27] + g * 256);
  }
}

constexpr int G2_STAGE = 384 * 64;
typedef int i32x4_t __attribute__((ext_vector_type(4)));
DEV i32x4_t make_srd(const void* p) {
  const unsigned long long a = (unsigned long long)p;
  i32x4_t r;
  r[0] = (int)(unsigned)(a & 0xffffffffull);
  r[1] = (int)(unsigned)((a >> 32) & 0xffffull);
  r[2] = -1;
  r[3] = 0x00020000;
  return r;
}
DEV void dma16(const i32x4_t& srd, unsigned voff, unsigned soff, unsigned m0v) {
  asm volatile("s_mov_b32 m0, %0\n\ts_nop 0\n\tbuffer_load_dwordx4 %1, %2, %3 offen lds"
               :: "s"(m0v), "v"(voff), "s"(srd), "s"(soff) : "m0", "memory");
}

DEV void gemm_mainloop(const u16* __restrict__ P, int ldp, const u16* __restrict__ Q, int ldq, int K, char* smem,
                       f32x4 (&acc)[8][4], const u16* __restrict__ Pn, const u16* __restrict__ Qn, int& st) {
  const int tid = otid(), lane = tid & 63, wave = tid >> 6;
  const int wp = wave >> 1, wq = wave & 1, l15 = lane & 15, q4 = lane >> 4;
#pragma unroll
  for (int a = 0; a < 8; ++a)
#pragma unroll
    for (int b = 0; b < 4; ++b) acc[a][b] = f32x4{0.f, 0.f, 0.f, 0.f};
  const int lr = tid >> 2, lc = ((tid & 3) ^ ((0x78 >> (2 * ((tid >> 4) & 3))) & 3)) * 8;
  const unsigned loff = (unsigned)(lr * 32 + lc) * 2u;
  const unsigned kstP = (unsigned)ldp * 64u, kstQ = (unsigned)ldq * 64u;
  const i32x4_t srdP = make_srd(P), srdQ = make_srd(Q);
  const i32x4_t srdPn = make_srd(Pn ? Pn : P), srdQn = make_srd(Qn ? Qn : Q);
  const bool has_next = (Pn != nullptr);
  const unsigned lds0 = (unsigned)__builtin_amdgcn_readfirstlane((int)((unsigned)(size_t)(__attribute__((address_space(3))) char*)smem + (unsigned)wave * 1024u));
  const int nk = K >> 5;
  const int swz = (q4 ^ ((0x78 >> (2 * ((l15 >> 2) & 3))) & 3)) * 16;
  const int prd = (wp * 128 + l15) * 64 + swz;
  const int qrd = (256 + wq * 64 + l15) * 64 + swz;
  for (int kt = 0; kt < nk; ++kt) {
    if (kt + 1 < nk || has_next) asm volatile("s_waitcnt vmcnt(6)" ::: "memory");
    else asm volatile("s_waitcnt vmcnt(0)" ::: "memory");
    __builtin_amdgcn_s_barrier();
    asm volatile("" ::: "memory");
    {
      const int st2 = (st >= 1) ? st - 1 : 2;
      const unsigned sd_ = lds0 + (unsigned)st2 * G2_STAGE;
      if (kt + 2 < nk) {
        const unsigned gp_ = (unsigned)(kt + 2) * kstP, gq_ = (unsigned)(kt + 2) * kstQ;
#pragma unroll
        for (int i_ = 0; i_ < 4; ++i_) dma16(srdP, loff, gp_ + i_ * 4096, sd_ + i_ * 4096);
#pragma unroll
        for (int i_ = 0; i_ < 2; ++i_) dma16(srdQ, loff, gq_ + i_ * 4096, sd_ + (4 + i_) * 4096);
      } else if (has_next) {
        const unsigned gp_ = (unsigned)(kt + 2 - nk) * kstP, gq_ = (unsigned)(kt + 2 - nk) * kstQ;
#pragma unroll
        for (int i_ = 0; i_ < 4; ++i_) dma16(srdPn, loff, gp_ + i_ * 4096, sd_ + i_ * 4096);
#pragma unroll
        for (int i_ = 0; i_ < 2; ++i_) dma16(srdQn, loff, gq_ + i_ * 4096, sd_ + (4 + i_) * 4096);
      }
    }
    const char* sb = smem + st * G2_STAGE;
    bf16x8 pf[8], qf[4];
#pragma unroll
    for (int b = 0; b < 4; ++b) qf[b] = *(const bf16x8*)(sb + qrd + b * 1024);
#pragma unroll
    for (int a = 0; a < 8; ++a) pf[a] = *(const bf16x8*)(sb + prd + a * 1024);
    __builtin_amdgcn_s_setprio(1);
#pragma unroll
    for (int a = 0; a < 8; ++a)
#pragma unroll
      for (int b = 0; b < 4; ++b) acc[a][b] = MFMA16(pf[a], qf[b], acc[a][b]);
    __builtin_amdgcn_s_setprio(0);
    st = (st == 2) ? 0 : st + 1;
  }
}

DEV void gemm_prime(const u16* __restrict__ P, int ldp, const u16* __restrict__ Q, int ldq, int K, char* smem) {
  const int tid = otid(), wave = tid >> 6;
  const int lr = tid >> 2, lc = ((tid & 3) ^ ((0x78 >> (2 * ((tid >> 4) & 3))) & 3)) * 8;
  const unsigned loff = (unsigned)(lr * 32 + lc) * 2u;
  const unsigned kstP = (unsigned)ldp * 64u, kstQ = (unsigned)ldq * 64u;
  const i32x4_t srdP = make_srd(P), srdQ = make_srd(Q);
  const unsigned lds0 = (unsigned)__builtin_amdgcn_readfirstlane((int)((unsigned)(size_t)(__attribute__((address_space(3))) char*)smem + (unsigned)wave * 1024u));
#pragma unroll
  for (int kt = 0; kt < 2; ++kt) {
    const unsigned sd_ = lds0 + (unsigned)kt * G2_STAGE;
#pragma unroll
    for (int i_ = 0; i_ < 4; ++i_) dma16(srdP, loff, kt * kstP + i_ * 4096, sd_ + i_ * 4096);
#pragma unroll
    for (int i_ = 0; i_ < 2; ++i_) dma16(srdQ, loff, kt * kstQ + i_ * 4096, sd_ + (4 + i_) * 4096);
  }
}

struct EpiArgs {
  void* out;
  int ldo;
  float s;
  const float* colscale;
  const float* xin;
  float* xf;
  u16* xb;
  const float* lng;
  const float* lnb;
  unsigned long long* slots;
  unsigned* flags;
};

template <int EPI>
DEV void gemm_epilogue(f32x4 (&acc)[8][4], int p0, int q0, const EpiArgs& ea, char* smem) {
  const int tid = otid(), lane = tid & 63, wave = tid >> 6;
  const int wp = wave >> 1, wq = wave & 1, l15 = lane & 15, q4 = lane >> 4;
  if (EPI == 4) {
    float* red = (float*)(smem + 3 * G2_STAGE);
    float* stat = red + 512;
    const int pi = p0 >> 8, qi = q0 >> 7;
    float rs[4], rq[4];
#pragma unroll
    for (int b = 0; b < 4; ++b) {
      rs[b] = 0.f; rq[b] = 0.f;
      const size_t q = q0 + wq * 64 + b * 16 + l15;
#pragma unroll
      for (int a = 0; a < 8; ++a) {
        const int pp = p0 + wp * 128 + a * 16 + q4 * 4;
        const float4 x = *(const float4*)(ea.xin + q * 1024 + pp);
        f32x4 y;
        y[0] = ALPHA * x.x + ea.s * acc[a][b][0];
        y[1] = ALPHA * x.y + ea.s * acc[a][b][1];
        y[2] = ALPHA * x.z + ea.s * acc[a][b][2];
        y[3] = ALPHA * x.w + ea.s * acc[a][b][3];
        acc[a][b] = y;
        rs[b] += (y[0] + y[1]) + (y[2] + y[3]);
        rq[b] += (y[0] * y[0] + y[1] * y[1]) + (y[2] * y[2] + y[3] * y[3]);
        if (a == 7) __builtin_amdgcn_sched_barrier(0);
      }
      rs[b] += __shfl_xor(rs[b], 16); rs[b] += __shfl_xor(rs[b], 32);
      rq[b] += __shfl_xor(rq[b], 16); rq[b] += __shfl_xor(rq[b], 32);
      if (q4 == 0) {
        red[(wp * 128 + wq * 64 + b * 16 + l15) * 2] = rs[b];
        red[(wp * 128 + wq * 64 + b * 16 + l15) * 2 + 1] = rq[b];
      }
    }
    __syncthreads();
    unsigned long long* slot = ea.slots + ((size_t)qi * 4) * 128;
    if (tid < 128) {
      const float S = red[tid * 2] + red[(128 + tid) * 2];
      const float Q = red[tid * 2 + 1] + red[(128 + tid) * 2 + 1];
      const unsigned long long v = ((unsigned long long)__float_as_uint(Q) << 32) | (unsigned long long)__float_as_uint(S);
      __hip_atomic_store(slot + (size_t)pi * 128 + tid, v, __ATOMIC_RELAXED, __HIP_MEMORY_SCOPE_AGENT);
    }
    asm volatile("s_waitcnt vmcnt(0)" ::: "memory");
    __syncthreads();
    if (tid == 0) {
      __hip_atomic_fetch_add(ea.flags + qi, 1u, __ATOMIC_RELAXED, __HIP_MEMORY_SCOPE_AGENT);
      unsigned sp = 0;
      while (__hip_atomic_load(ea.flags + qi, __ATOMIC_RELAXED, __HIP_MEMORY_SCOPE_AGENT) < 4u) {
        __builtin_amdgcn_s_sleep(1);
        if (++sp > (1u << 22)) break;
      }
    }
    __syncthreads();
    if (tid < 128) {
      float S = 0.f, Q = 0.f;
#pragma unroll
      for (int pj = 0; pj < 4; ++pj) {
        const unsigned long long v = __hip_atomic_load(slot + (size_t)pj * 128 + tid, __ATOMIC_RELAXED, __HIP_MEMORY_SCOPE_AGENT);
        S += __uint_as_float((unsigned)(v & 0xffffffffull));
        Q += __uint_as_float((unsigned)(v >> 32));
      }
      const float mu = S * (1.f / 1024.f);
      const float var = fmaxf(Q * (1.f / 1024.f) - mu * mu, 0.f);
      stat[tid * 2] = mu;
      stat[tid * 2 + 1] = rsqrtf(var + 1e-5f);
    }
    __syncthreads();
    float mu4[4], rs4[4];
#pragma unroll
    for (int b = 0; b < 4; ++b) { const int r = wq * 64 + b * 16 + l15; mu4[b] = stat[r * 2]; rs4[b] = stat[r * 2 + 1]; }
#pragma unroll
    for (int a = 0; a < 8; ++a) {
      const int pp = p0 + wp * 128 + a * 16 + q4 * 4;
      const float4 gg = *(const float4*)(ea.lng + pp), bb = *(const float4*)(ea.lnb + pp);
#pragma unroll
      for (int b = 0; b < 4; ++b) {
        const size_t q = q0 + wq * 64 + b * 16 + l15;
        float4 y;
        y.x = (acc[a][b][0] - mu4[b]) * rs4[b] * gg.x + bb.x;
        y.y = (acc[a][b][1] - mu4[b]) * rs4[b] * gg.y + bb.y;
        y.z = (acc[a][b][2] - mu4[b]) * rs4[b] * gg.z + bb.z;
        y.w = (acc[a][b][3] - mu4[b]) * rs4[b] * gg.w + bb.w;
        *(float4*)(ea.xf + q * 1024 + pp) = y;
        *(uint2*)(ea.xb + kb32(q, pp, MTOK)) = make_uint2(pk2(y.x, y.y), pk2(y.z, y.w));
      }
      if (a & 1) __builtin_amdgcn_sched_barrier(0);
    }
  } else if (EPI == 0) {
    u16* out = (u16*)ea.out;
#pragma unroll
    for (int b = 0; b < 4; ++b) {
      const size_t q = q0 + wq * 64 + b * 16 + l15;
#pragma unroll
      for (int a = 0; a < 8; ++a) {
        const int pp = p0 + wp * 128 + a * 16 + q4 * 4;
        f32x4 v = acc[a][b];
        *(uint2*)(out + q * ea.ldo + pp) = make_uint2(pk2(v[0], v[1]), pk2(v[2], v[3]));
      }
    }
  } else if (EPI == 1) {
    u16* out = (u16*)ea.out;
#pragma unroll
    for (int b = 0; b < 4; ++b) {
      const size_t q = q0 + wq * 64 + b * 16 + l15;
#pragma unroll
      for (int a = 0; a < 4; ++a) {
        const int f = ((p0 + wp * 128) >> 1) + a * 16 + q4 * 4;
        f32x4 g = acc[2 * a][b], u = acc[2 * a + 1][b];
        float r[4];
#pragma unroll
        for (int j = 0; j < 4; ++j) r[j] = g[j] / (1.f + __expf(-g[j])) * u[j];
        *(uint2*)(out + kb32(q, f, MTOK)) = make_uint2(pk2(r[0], r[1]), pk2(r[2], r[3]));
      }
    }
  } else {
    u16* out = (u16*)ea.out;
#pragma unroll
    for (int b = 0; b < 4; ++b) {
      const size_t q = q0 + wq * 64 + b * 16 + l15;
#pragma unroll
      for (int a = 0; a < 8; ++a) {
        const int pp = p0 + wp * 128 + a * 16 + q4 * 4;
        f32x4 v = acc[a][b];
        float4 cs = make_float4(ea.s, ea.s, ea.s, ea.s);
        if (ea.colscale) { float4 c = *(const float4*)(ea.colscale + pp); cs.x *= c.x; cs.y *= c.y; cs.z *= c.z; cs.w *= c.w; }
        *(uint2*)(out + q * ea.ldo + pp) = make_uint2(pk2(cs.x * v[0], cs.y * v[1]), pk2(cs.z * v[2], cs.w * v[3]));
      }
    }
  }
}

DEV void gemm_tile_coords(int t, int nPt, int nQt, bool pfast, int G, int& pi, int& qi) {
  const int nT = pfast ? nPt : nQt, nW = pfast ? nQt : nPt;
  int ti, wi;
  if ((nT & 63) == 0 && (G & 7) == 0) {
    const int x = t & 7, u = t >> 3;
    const int per = nW * 8;
    const int qgrp = u / per, rem = u - qgrp * per;
    wi = rem >> 3;
    ti = ((qgrp * 8 + (rem & 7)) << 3) + x;
  } else { ti = t % nT; wi = t / nT; }
  if (pfast) { pi = ti; qi = wi; } else { qi = ti; pi = wi; }
}

template <int EPI>
DEV void gemm_job(int& base, const u16* P, int ldp, int nPt, const u16* Q, int ldq, int nQt, int K, bool pfast,
                  const EpiArgs& ea, char* smem, size_t qofs_per_pi = 0) {
  const int nt = nPt * nQt, G = gridDim.x;
  const int first = ((int)blockIdx.x - (base % G) + G) % G;
  base += nt;
  if (first >= nt) return;
  int pi, qi;
  gemm_tile_coords(first, nPt, nQt, pfast, G, pi, qi);
  asm volatile("s_waitcnt vmcnt(0)" ::: "memory");
  __syncthreads();
  gemm_prime(P + (size_t)pi * 256 * 32, ldp, Q + (size_t)qi * 128 * 32 + (size_t)pi * qofs_per_pi, ldq, K, smem);
  int st = 0;
  for (int t = first; t < nt; t += G) {
    const u16* Pt = P + (size_t)pi * 256 * 32;
    const u16* Qt = Q + (size_t)qi * 128 * 32 + (size_t)pi * qofs_per_pi;
    const int p0 = pi * 256, q0 = qi * 128;
    const u16* Pn = nullptr; const u16* Qn = nullptr;
    if (t + G < nt) {
      gemm_tile_coords(t + G, nPt, nQt, pfast, G, pi, qi);
      Pn = P + (size_t)pi * 256 * 32;
      Qn = Q + (size_t)qi * 128 * 32 + (size_t)pi * qofs_per_pi;
    }
    f32x4 acc[8][4];
    gemm_mainloop(Pt, ldp, Qt, ldq, K, smem, acc, Pn, Qn, st);
    gemm_epilogue<EPI>(acc, p0, q0, ea, smem);
  }
  __builtin_amdgcn_s_barrier();
  asm volatile("" ::: "memory");
}

DEV void phase_ln(const Params& p, const float* g, const float* b, const u16* z, const float* xin) {
  const int tid = otid();
  const int wave = tid >> 6, lane = tid & 63;
  u16* xb = (u16*)(p.ws + OFF_XB);
  float4 gg[4], bb[4];
#pragma unroll
  for (int i = 0; i < 4; ++i) { gg[i] = *(const float4*)(g + i * 256 + lane * 4); bb[i] = *(const float4*)(b + i * 256 + lane * 4); }
  const int stride = gridDim.x * 8;
  int row0 = (blockIdx.x * 4 + wave) * 2;
  float4 nx[2][4];
  uint2 nz[2][4];
  if (row0 < MTOK) {
#pragma unroll
    for (int r = 0; r < 2; ++r)
#pragma unroll
      for (int i = 0; i < 4; ++i) {
        nx[r][i] = *(const float4*)(xin + (size_t)(row0 + r) * 1024 + i * 256 + lane * 4);
        nz[r][i] = *(const uint2*)(z + (size_t)(row0 + r) * 1024 + i * 256 + lane * 4);
      }
  }
  for (; row0 < MTOK; row0 += stride) {
    float4 v[2][4];
#pragma unroll
    for (int r = 0; r < 2; ++r)
#pragma unroll
      for (int i = 0; i < 4; ++i) {
        v[r][i].x = ALPHA * nx[r][i].x + bflo(nz[r][i].x);
        v[r][i].y = ALPHA * nx[r][i].y + bfhi(nz[r][i].x);
        v[r][i].z = ALPHA * nx[r][i].z + bflo(nz[r][i].y);
        v[r][i].w = ALPHA * nx[r][i].w + bfhi(nz[r][i].y);
      }
    if (row0 + stride < MTOK) {
#pragma unroll
      for (int r = 0; r < 2; ++r)
#pragma unroll
        for (int i = 0; i < 4; ++i) {
          nx[r][i] = *(const float4*)(xin + (size_t)(row0 + stride + r) * 1024 + i * 256 + lane * 4);
          nz[r][i] = *(const uint2*)(z + (size_t)(row0 + stride + r) * 1024 + i * 256 + lane * 4);
        }
    }
#pragma unroll
    for (int r = 0; r < 2; ++r) {
      float s = 0.f;
#pragma unroll
      for (int i = 0; i < 4; ++i) s += v[r][i].x + v[r][i].y + v[r][i].z + v[r][i].w;
#pragma unroll
      for (int o = 32; o > 0; o >>= 1) s += __shfl_xor(s, o);
      const float mu = s * (1.f / 1024.f);
      float ss = 0.f;
#pragma unroll
      for (int i = 0; i < 4; ++i) {
        v[r][i].x -= mu; v[r][i].y -= mu; v[r][i].z -= mu; v[r][i].w -= mu;
        ss += v[r][i].x * v[r][i].x + v[r][i].y * v[r][i].y + v[r][i].z * v[r][i].z + v[r][i].w * v[r][i].w;
      }
#pragma unroll
      for (int o = 32; o > 0; o >>= 1) ss += __shfl_xor(ss, o);
      const float rs = rsqrtf(ss * (1.f / 1024.f) + 1e-5f);
      float* xr = p.xf + (size_t)(row0 + r) * 1024;
#pragma unroll
      for (int i = 0; i < 4; ++i) {
        const int c = i * 256 + lane * 4;
        float4 y;
        y.x = v[r][i].x * rs * gg[i].x + bb[i].x;
        y.y = v[r][i].y * rs * gg[i].y + bb[i].y;
        y.z = v[r][i].z * rs * gg[i].z + bb[i].z;
        y.w = v[r][i].w * rs * gg[i].w + bb[i].w;
        *(float4*)(xr + c) = y;
        *(uint2*)(xb + kb32(row0 + r, c, MTOK)) = make_uint2(pk2(y.x, y.y), pk2(y.z, y.w));
      }
    }
  }
}

constexpr int VSTR = 144;

template <int D>
DEV void load_kv_tile(const u16* __restrict__ kptr, size_t ldk, const u16* __restrict__ vtptr, size_t ldv, char* Ks,
                      char* Vs) {
  constexpr int KSTR = D * 2 + 16;
  constexpr int CPR = D / 8;
  const int tid = otid();
#pragma unroll
  for (int i = 0; i < D / 32; ++i) {
    int c = tid + 256 * i;
    int row = c / CPR, kc = c % CPR;
    uint4 v = *(const uint4*)(kptr + (size_t)row * ldk + kc * 8);
    *(uint4*)(Ks + row * KSTR + kc * 16) = v;
  }
#pragma unroll
  for (int i = 0; i < D / 32; ++i) {
    int c = tid + 256 * i;
    int d = c >> 3, kc = c & 7;
    uint4 v = *(const uint4*)(vtptr + (size_t)d * ldv + kc * 8);
    *(uint4*)(Vs + d * VSTR + kc * 16) = v;
  }
}

DEV int dense_gk(int r) { const int i = (r & 15) >> 1; return i ^ (((i + 2) >> 2) & 1); }
DEV int dense_gv(int d) { return (d >> 1) & 7; }
DEV void dma_kv_tile(const u16* __restrict__ kptr, size_t ldk, const u16* __restrict__ vtptr, size_t ldv, char* Kb,
                     char* Vb, int tid) {
#pragma unroll
  for (int j = 0; j < 2; ++j) {
    const int L = tid + 256 * j, row = L >> 3, cp = L & 7;
    __builtin_amdgcn_global_load_lds((const unsigned*)(kptr + (size_t)row * ldk + ((cp ^ dense_gk(row)) * 8)),
                                     (unsigned*)(Kb + L * 16), 16, 0, 0);
    __builtin_amdgcn_global_load_lds((const unsigned*)(vtptr + (size_t)row * ldv + ((cp ^ dense_gv(row)) * 8)),
                                     (unsigned*)(Vb + L * 16), 16, 0, 0);
  }
}

template <int D, int RT, bool DENSE, class F>
DEV void flash_block(f32x4 (&o)[RT][D / 16], float (&m)[RT], float (&l)[RT], const bf16x8 (&qf)[RT][D / 32],
                     const char* Ks, const char* Vs, const F& f) {
  constexpr int KSTR = D * 2 + 16;
  const int lane = otid() & 63, l15 = lane & 15, q4 = lane >> 4;
  const int gkl = dense_gk(l15), gvl = dense_gv(l15);
  f32x4 s[RT][4];
#pragma unroll
  for (int ks = 0; ks < 4; ++ks) {
#pragma unroll
    for (int rt = 0; rt < RT; ++rt) {
      s[rt][ks][0] = f.init(rt, ks * 16 + 0); s[rt][ks][1] = f.init(rt, ks * 16 + 1);
      s[rt][ks][2] = f.init(rt, ks * 16 + 2); s[rt][ks][3] = f.init(rt, ks * 16 + 3);
    }
#pragma unroll
    for (int ds = 0; ds < D / 32; ++ds) {
      bf16x8 kf = DENSE ? *(const bf16x8*)(Ks + (ks * 16 + l15) * 128 + (((ds * 4 + q4) ^ gkl) * 16))
                        : *(const bf16x8*)(Ks + (ks * 16 + l15) * KSTR + ds * 64 + q4 * 16);
#pragma unroll
      for (int rt = 0; rt < RT; ++rt) s[rt][ks] = MFMA16(kf, qf[rt][ds], s[rt][ks]);
    }
    if (D > 64) __builtin_amdgcn_sched_barrier(0);
  }
#pragma unroll
  for (int rt = 0; rt < RT; ++rt) {
    float mx = fmaxf(fmaxf(s[rt][0][0], s[rt][0][1]), fmaxf(s[rt][0][2], s[rt][0][3]));
#pragma unroll
    for (int ks = 1; ks < 4; ++ks) mx = fmaxf(mx, fmaxf(fmaxf(s[rt][ks][0], s[rt][ks][1]), fmaxf(s[rt][ks][2], s[rt][ks][3])));
    mx = fmaxf(mx, __shfl_xor(mx, 16));
    mx = fmaxf(mx, __shfl_xor(mx, 32));
    const float mn = (mx > m[rt] + 8.f) ? mx : m[rt];
    const float a = __builtin_amdgcn_exp2f(m[rt] - mn);
    m[rt] = mn;
    float ls = 0.f;
#pragma unroll
    for (int ks = 0; ks < 4; ++ks)
#pragma unroll
      for (int j = 0; j < 4; ++j) {
        const float pv = __builtin_amdgcn_exp2f(s[rt][ks][j] - mn);
        ls += pv;
        s[rt][ks][j] = pv;
      }
    l[rt] = l[rt] * a + ls;
    if (__any(a != 1.f)) {
#pragma unroll
      for (int dd = 0; dd < D / 16; ++dd) {
        o[rt][dd][0] *= a; o[rt][dd][1] *= a; o[rt][dd][2] *= a; o[rt][dd][3] *= a;
      }
    }
  }
#pragma unroll
  for (int kh = 0; kh < 2; ++kh) {
    bf16x8 pf[RT];
#pragma unroll
    for (int rt = 0; rt < RT; ++rt) {
      uint4 w;
      w.x = pk2(s[rt][2 * kh][0], s[rt][2 * kh][1]);
      w.y = pk2(s[rt][2 * kh][2], s[rt][2 * kh][3]);
      w.z = pk2(s[rt][2 * kh + 1][0], s[rt][2 * kh + 1][1]);
      w.w = pk2(s[rt][2 * kh + 1][2], s[rt][2 * kh + 1][3]);
      pf[rt] = __builtin_bit_cast(bf16x8, w);
    }
#pragma unroll
    for (int dd = 0; dd < D / 16; ++dd) {
      uint2 v0, v1;
      if (DENSE) {
        const char* vr = Vs + (dd * 16 + l15) * 128 + (q4 & 1) * 8;
        v0 = *(const uint2*)(vr + (((4 * kh + (q4 >> 1)) ^ gvl) * 16));
        v1 = *(const uint2*)(vr + (((4 * kh + 2 + (q4 >> 1)) ^ gvl) * 16));
      } else {
        const char* vp = Vs + (dd * 16 + l15) * VSTR + (32 * kh + q4 * 4) * 2;
        v0 = *(const uint2*)(vp);
        v1 = *(const uint2*)(vp + 32);
      }
      uint4 w = make_uint4(v0.x, v0.y, v1.x, v1.y);
      bf16x8 vf = __builtin_bit_cast(bf16x8, w);
#pragma unroll
      for (int rt = 0; rt < RT; ++rt) o[rt][dd] = MFMA16(vf, pf[rt], o[rt][dd]);
      if (D > 64 && (dd & 3) == 3) __builtin_amdgcn_sched_barrier(0);
    }
  }
}

template <int RT>
DEV void flash_finish_l(float (&l)[RT]) {
#pragma unroll
  for (int rt = 0; rt < RT; ++rt) {
    float v = l[rt];
    v += __shfl_xor(v, 16);
    v += __shfl_xor(v, 32);
    l[rt] = v;
  }
}

constexpr float NEG_INF = -__builtin_huge_valf();
struct FNoMask {
  DEV float init(int, int) const { return 0.f; }
};
template <bool MASKED>
struct FBand {
  float dq[2];
  float sd[2];
  float slope[2];
  float W;
  DEV float init(int rt, int c) const {
    const float bias = __builtin_fmaf(slope[rt], (float)c, -sd[rt]);
    if (!MASKED) return bias;
    const float d = dq[rt] - (float)c;
    return (d >= 0.f && d < W) ? bias : NEG_INF;
  }
};
template <bool MASKED>
struct FSel {
  float dq[2];
  float sd[2];
  float slope[2];
  DEV float init(int rt, int c) const {
    const float bias = __builtin_fmaf(slope[rt], (float)c, -sd[rt]);
    if (!MASKED) return bias;
    return (dq[rt] - (float)c >= 0.f) ? bias : NEG_INF;
  }
};

DEV void phase_swa_attn(const Params& p, char* smem) {
  const u16* proj = (const u16*)(p.ws + OFF_BIG);
  const u16* vt = (const u16*)(p.ws + OFF_BIG + BIG_VT2);
  u16* ao = (u16*)(p.ws + OFF_AO);
  const float* sinks = p.in[14];
  const int tid = otid();
  const int lane = tid & 63, wave = tid >> 6, l15 = lane & 15, q4 = lane >> 4;
  for (int item = blockIdx.x; item < 16 * 4 * 64; item += gridDim.x) {
    const int tb = item & 63, g = (item >> 6) & 3, b = item >> 8;
    const int t0 = tb * 32;
    bf16x8 qf[2][2];
    f32x4 o[2][4];
    float m[2], l[2], slope[2];
    int head[2], tokr[2];
#pragma unroll
    for (int rt = 0; rt < 2; ++rt) {
      const int r = wave * 32 + rt * 16 + l15;
      tokr[rt] = t0 + (r >> 2);
      head[rt] = g * 4 + (r & 3);
      slope[rt] = LOG2E * exp2f(-0.5f * (float)(head[rt] + 1));
      const u16* qp = proj + (size_t)(b * SEQL + tokr[rt]) * 1280 + head[rt] * 64 + q4 * 8;
      qf[rt][0] = *(const bf16x8*)(qp);
      qf[rt][1] = *(const bf16x8*)(qp + 32);
      m[rt] = LOG2E * sinks[head[rt]];
      l[rt] = (q4 == 0) ? 1.f : 0.f;
#pragma unroll
      for (int dd = 0; dd < 4; ++dd) o[rt][dd] = f32x4{0.f, 0.f, 0.f, 0.f};
    }
    int kb0 = t0 - 127; kb0 = kb0 < 0 ? 0 : (kb0 & ~63);
    const int kb1 = t0 & ~63;
    __syncthreads();
    dma_kv_tile(proj + (size_t)(b * SEQL + kb1) * 1280 + 1024 + g * 64, 1280,
                vt + (size_t)(g * 64) * MTOK + b * SEQL + kb1, MTOK, smem, smem + 8192, tid);
    int bufi = 0;
    for (int kb = kb1; kb >= kb0; kb -= 64) {
      asm volatile("s_waitcnt vmcnt(0)" ::: "memory");
      __syncthreads();
      if (kb - 64 >= kb0)
        dma_kv_tile(proj + (size_t)(b * SEQL + kb - 64) * 1280 + 1024 + g * 64, 1280,
                    vt + (size_t)(g * 64) * MTOK + b * SEQL + kb - 64, MTOK, smem + (bufi ^ 1) * 16384,
                    smem + (bufi ^ 1) * 16384 + 8192, tid);
      const bool full = (t0 - (kb + 63) >= 0) && (t0 + 31 - kb < 128);
      const float dq0 = (float)(tokr[0] - kb - q4 * 4), dq1 = (float)(tokr[1] - kb - q4 * 4);
      if (full) {
        FBand<false> f{{dq0, dq1}, {slope[0] * dq0, slope[1] * dq1}, {slope[0], slope[1]}, 128.f};
        flash_block<64, 2, true>(o, m, l, qf, smem + bufi * 16384, smem + bufi * 16384 + 8192, f);
      } else {
        FBand<true> f{{dq0, dq1}, {slope[0] * dq0, slope[1] * dq1}, {slope[0], slope[1]}, 128.f};
        flash_block<64, 2, true>(o, m, l, qf, smem + bufi * 16384, smem + bufi * 16384 + 8192, f);
      }
      bufi ^= 1;
    }
    flash_finish_l<2>(l);
#pragma unroll
    for (int rt = 0; rt < 2; ++rt) {
      const float inv = 1.f / l[rt];
#pragma unroll
      for (int dd = 0; dd < 4; ++dd) {
        f32x4 v = o[rt][dd];
        *(uint2*)(ao + kb32((size_t)(b * SEQL + tokr[rt]), head[rt] * 64 + dd * 16 + q4 * 4, MTOK)) =
            make_uint2(pk2(v[0] * inv, v[1] * inv), pk2(v[2] * inv, v[3] * inv));
      }
    }
  }
}

DEV void phase_xattn(const Params& p, char* smem) {
  const u16* qb = (const u16*)(p.ws + OFF_BIG);
  const u16* kbuf = (const u16*)(p.ws + OFF_KB);
  const u16* vtb = (const u16*)(p.ws + OFF_VT);
  u16* ao = (u16*)(p.ws + OFF_AO);
  char* Ks = smem; char* Vs = smem + 64 * (512 + 16);
  const int lane = otid() & 63, wave = otid() >> 6, l15 = lane & 15, q4 = lane >> 4;
  FNoMask f;
  for (int item = blockIdx.x; item < 16 * 4 * 32; item += gridDim.x) {
    const int tb = item & 31, h = (item >> 5) & 3, b = item >> 7;
    const int tok = tb * 64 + wave * 16 + l15;
    bf16x8 qf[1][8];
    f32x4 o[1][16];
    float m[1], l[1];
    const u16* qp = qb + (size_t)(b * SEQL + tok) * 1024 + h * 256 + q4 * 8;
#pragma unroll
    for (int ds = 0; ds < 8; ++ds) qf[0][ds] = *(const bf16x8*)(qp + ds * 32);
#pragma unroll
    for (int dd = 0; dd < 16; ++dd) o[0][dd] = f32x4{0.f, 0.f, 0.f, 0.f};
    m[0] = NEGBIG; l[0] = 0.f;
    for (int kb = 0; kb < 256; kb += 64) {
      __syncthreads();
      load_kv_tile<256>(kbuf + (size_t)(b * 256 + kb) * 1024 + h * 256, 1024,
                        vtb + (size_t)(h * 256) * 4096 + b * 256 + kb, 4096, Ks, Vs);
      __syncthreads();
      flash_block<256, 1, false>(o, m, l, qf, Ks, Vs, f);
    }
    flash_finish_l<1>(l);
    const float inv = 1.f / l[0];
#pragma unroll
    for (int dd = 0; dd < 16; ++dd) {
      f32x4 v = o[0][dd];
      *(uint2*)(ao + kb32((size_t)(b * SEQL + tok), h * 256 + dd * 16 + q4 * 4, MTOK)) =
          make_uint2(pk2(v[0] * inv, v[1] * inv), pk2(v[2] * inv, v[3] * inv));
    }
  }
}

DEV float gelu_tanh(float x) {
  float u = 0.7978845608028654f * (x + 0.044715f * x * x * x);
  return 0.5f * x * (1.f + tanhf(u));
}
constexpr int NSA_LD = 1792;
DEV void phase_nsa_compress(const Params& p, char* smem) {
  const u16* proj = (const u16*)(p.ws + OFF_BIG);
  u16* cmpb = (u16*)(p.ws + OFF_CMP);
  const float* pos = p.in[17];
  const float* w1 = p.in[18];
  const float* w2 = p.in[19];
  float* in_s = (float*)smem;
  float* red_s = in_s + 144 * 64;
  float* hid_s = red_s + 4 * 8 * 64;
  const int tid = otid(), e = tid & 63, part = tid >> 6;
  for (int item = blockIdx.x; item < 2 * 16 * 2 * 16; item += gridDim.x) {
    const int ng = item & 15, g = (item >> 4) & 1, b = (item >> 5) & 15, which = item >> 9;
    const int n0 = ng * 8;
    const int cnt = (127 - n0) < 8 ? (127 - n0) : 8;
    const int tbase = 16 * n0;
    const int coff = 1024 + which * 128 + g * 64;
    __syncthreads();
    for (int idx = tid; idx < 144 * 8; idx += 256) {
      const int row = idx >> 3, c8 = idx & 7;
      const int t = tbase + row;
      float vals[8];
      if (t < SEQL) {
        uint4 v = *(const uint4*)(proj + (size_t)(b * SEQL + t) * NSA_LD + coff + c8 * 8);
        vals[0] = bflo(v.x); vals[1] = bfhi(v.x); vals[2] = bflo(v.y); vals[3] = bfhi(v.y);
        vals[4] = bflo(v.z); vals[5] = bfhi(v.z); vals[6] = bflo(v.w); vals[7] = bfhi(v.w);
      } else {
#pragma unroll
        for (int j = 0; j < 8; ++j) vals[j] = 0.f;
      }
#pragma unroll
      for (int j = 0; j < 8; ++j) in_s[row * 64 + c8 * 8 + j] = vals[j];
    }
    __syncthreads();
    float acc[8];
#pragma unroll
    for (int nn = 0; nn < 8; ++nn) acc[nn] = 0.f;
    float accp = 0.f;
    for (int l = part * 8; l < part * 8 + 8; ++l) {
      const float* wrow = w1 + ((size_t)(which * 32 + l) * 64) * 64 + e;
      const float* prow = pos + (which * 32 + l) * 64;
#pragma unroll 4
      for (int d = 0; d < 64; ++d) {
        const float w = wrow[d * 64];
        accp += prow[d] * w;
#pragma unroll
        for (int nn = 0; nn < 8; ++nn) acc[nn] += in_s[(16 * nn + l) * 64 + d] * w;
      }
    }
#pragma unroll
    for (int nn = 0; nn < 8; ++nn) red_s[(part * 8 + nn) * 64 + e] = acc[nn] + accp;
    __syncthreads();
#pragma unroll
    for (int h2 = 0; h2 < 2; ++h2) {
      const int nn = part + 4 * h2;
      float hsum = red_s[(0 * 8 + nn) * 64 + e] + red_s[(1 * 8 + nn) * 64 + e] + red_s[(2 * 8 + nn) * 64 + e] +
                   red_s[(3 * 8 + nn) * 64 + e];
      hid_s[nn * 64 + e] = gelu_tanh(hsum);
    }
    __syncthreads();
#pragma unroll
    for (int h2 = 0; h2 < 2; ++h2) {
      const int nn = part + 4 * h2;
      float s = 0.f;
      const float* w2p = w2 + (size_t)which * 4096 + e;
#pragma unroll 8
      for (int k = 0; k < 64; ++k) s += hid_s[nn * 64 + k] * w2p[k * 64];
      {
        const float sv = (nn < cnt) ? s : 0.f;
        const size_t bg = (size_t)b * 2 + g;
        if (which == 0) cmpb[(bg * 128 + n0 + nn) * 64 + e] = f2bf(sv);
        else cmpb[(size_t)32 * 128 * 64 + (bg * 64 + e) * 128 + n0 + nn] = f2bf(sv);
      }
    }
  }
}

struct FCmp {
  float nq[2];
  float bq[2];
  float slope16[2];
  DEV float init(int rt, int c) const {
    return ((float)c <= nq[rt]) ? __builtin_fmaf(slope16[rt], (float)c, bq[rt]) : NEG_INF;
  }
};

DEV void phase_nsa_attn(const Params& p, char* smem) {
  const u16* proj = (const u16*)(p.ws + OFF_BIG);
  const u16* vt = (const u16*)(p.ws + OFF_BIG + BIG_VT2);
  const u16* kcb = (const u16*)(p.ws + OFF_CMP);
  const u16* vcb = kcb + (size_t)32 * 128 * 64;
  u16* ao = (u16*)(p.ws + OFF_AO);
  char* KC = smem + 32768;
  float* impA = (float*)(smem + 49152);
  float* impC = (float*)(smem + 51200);
  u32* selm = (u32*)(smem + 53248);
  const int tid = otid();
  const int lane = tid & 63, wave = tid >> 6, l15 = lane & 15, q4 = lane >> 4;
  for (int item = blockIdx.x; item < 16 * 2 * 128; item += gridDim.x) {
    const int tb = item & 127, g = (item >> 7) & 1, b = item >> 8;
    const int t0 = tb * 16;
    bf16x8 qf[2][2];
    int head[2], tokr[2];
    float slope[2];
#pragma unroll
    for (int rt = 0; rt < 2; ++rt) {
      const int r = wave * 32 + rt * 16 + l15;
      tokr[rt] = t0 + (r >> 3);
      head[rt] = g * 8 + (r & 7);
      slope[rt] = LOG2E * exp2f(-0.5f * (float)(head[rt] + 1));
      const u16* qp = proj + (size_t)(b * SEQL + tokr[rt]) * NSA_LD + head[rt] * 64 + q4 * 8;
      qf[rt][0] = *(const bf16x8*)(qp);
      qf[rt][1] = *(const bf16x8*)(qp + 32);
    }
    {
      f32x4 base[2][4];
      {
        f32x4 o[2][4];
        float m[2], l[2];
#pragma unroll
        for (int rt = 0; rt < 2; ++rt) {
          m[rt] = NEGBIG; l[rt] = 0.f;
#pragma unroll
          for (int dd = 0; dd < 4; ++dd) o[rt][dd] = f32x4{0.f, 0.f, 0.f, 0.f};
        }
        const int nvmax = (t0 + 15 >= 31) ? ((t0 + 15 - 31) >> 4) + 1 : 0;
        const int nkb = (nvmax + 63) >> 6;
        __syncthreads();
        for (int i = tid; i < 1024; i += 256) impA[i] = 0.f;
        for (int kb = 0; kb < nkb; ++kb)
          dma_kv_tile(kcb + (((size_t)b * 2 + g) * 128 + kb * 64) * 64, 64,
                      vcb + ((size_t)b * 2 + g) * 64 * 128 + kb * 64, 128, KC + kb * 8192, smem + kb * 16384 + 8192, tid);
        asm volatile("s_waitcnt vmcnt(0)" ::: "memory");
        __syncthreads();
        FCmp fc;
        float nvl[2];
#pragma unroll
        for (int rt = 0; rt < 2; ++rt) {
          nvl[rt] = (tokr[rt] >= 31) ? (float)((tokr[rt] - 31) >> 4) : -1.f;
          fc.slope16[rt] = 16.f * slope[rt];
        }
        for (int kb = 0; kb < nkb; ++kb) {
#pragma unroll
          for (int rt = 0; rt < 2; ++rt) {
            const float nb = (float)(kb * 64 + q4 * 4);
            fc.nq[rt] = nvl[rt] - nb;
            fc.bq[rt] = fc.slope16[rt] * nb - slope[rt] * ((float)tokr[rt] - 15.5f);
          }
          flash_block<64, 2, true>(o, m, l, qf, KC + kb * 8192, smem + kb * 16384 + 8192, fc);
        }
        flash_finish_l<2>(l);
        float linv[2];
#pragma unroll
        for (int rt = 0; rt < 2; ++rt) {
          linv[rt] = (l[rt] > 0.f) ? 1.f / l[rt] : 0.f;
          const float sc = linv[rt] / (1.f + __expf(-bf2f(proj[(size_t)(b * SEQL + tokr[rt]) * NSA_LD + 1536 + head[rt]])));
#pragma unroll
          for (int dd = 0; dd < 4; ++dd) {
            base[rt][dd][0] = o[rt][dd][0] * sc; base[rt][dd][1] = o[rt][dd][1] * sc;
            base[rt][dd][2] = o[rt][dd][2] * sc; base[rt][dd][3] = o[rt][dd][3] * sc;
          }
        }
        for (int kb = 0; kb < nkb; ++kb) {
          const char* Kc = KC + kb * 8192;
          const int gkl = dense_gk(l15);
#pragma unroll
          for (int rt = 0; rt < 2; ++rt) {
            const float nb = (float)(kb * 64 + q4 * 4);
            fc.nq[rt] = nvl[rt] - nb;
            fc.bq[rt] = fc.slope16[rt] * nb - slope[rt] * ((float)tokr[rt] - 15.5f);
          }
#pragma unroll
          for (int ks = 0; ks < 4; ++ks) {
            f32x4 s[2];
#pragma unroll
            for (int rt = 0; rt < 2; ++rt) {
              s[rt][0] = fc.init(rt, ks * 16 + 0); s[rt][1] = fc.init(rt, ks * 16 + 1);
              s[rt][2] = fc.init(rt, ks * 16 + 2); s[rt][3] = fc.init(rt, ks * 16 + 3);
            }
#pragma unroll
            for (int ds = 0; ds < 2; ++ds) {
              bf16x8 kf = *(const bf16x8*)(Kc + (ks * 16 + l15) * 128 + (((ds * 4 + q4) ^ gkl) * 16));
              s[0] = MFMA16(kf, qf[0][ds], s[0]);
              s[1] = MFMA16(kf, qf[1][ds], s[1]);
            }
#pragma unroll
            for (int rt = 0; rt < 2; ++rt) {
              float pa = 0.f, pc = 0.f;
#pragma unroll
              for (int j = 0; j < 4; ++j) {
                const float pr = __builtin_amdgcn_exp2f(s[rt][j] - m[rt]) * linv[rt];
                pa += pr;
                if (j == 3) pc = pr;
              }
              pa += __shfl_xor(pa, 1); pa += __shfl_xor(pa, 2); pa += __shfl_xor(pa, 4);
              pc += __shfl_xor(pc, 1); pc += __shfl_xor(pc, 2); pc += __shfl_xor(pc, 4);
              if ((l15 & 7) == 0) {
                const int tk = wave * 4 + rt * 2 + (l15 >> 3);
                const int a = kb * 16 + ks * 4 + q4;
                impA[tk * 32 + a] = pa;
                impC[tk * 32 + a] = pc;
              }
            }
          }
        }
      }
      __syncthreads();
      {
        const int tk = tid >> 4, mb2 = tid & 15;
        const int t = t0 + tk;
        const int cur = t >> 6;
        float sc2[2];
#pragma unroll
        for (int mm = 0; mm < 2; ++mm) {
          const int mb = mb2 * 2 + mm;
          const bool fm = (mb == 0) || (mb == cur) || (mb == cur - 1);
          sc2[mm] = (mb <= cur) ? impA[tk * 32 + mb] + (mb > 0 ? impC[tk * 32 + mb - 1] : 0.f) + (fm ? 1.0e4f : 0.f) : -1.f;
        }
        __syncthreads();
        impA[tk * 32 + mb2 * 2] = sc2[0];
        impA[tk * 32 + mb2 * 2 + 1] = sc2[1];
        __syncthreads();
        u32 bits = 0;
#pragma unroll
        for (int mm = 0; mm < 2; ++mm) {
          const int mb = mb2 * 2 + mm;
          if (mb <= cur) {
            const float sm = sc2[mm];
            int rank = 0;
            for (int m2 = 0; m2 <= cur; ++m2) {
              const float s2 = impA[tk * 32 + m2];
              rank += (s2 > sm || (s2 == sm && m2 < mb)) ? 1 : 0;
            }
            if (rank < 8) bits |= (1u << mb);
          }
        }
        bits |= __shfl_xor(bits, 1);
        bits |= __shfl_xor(bits, 2);
        bits |= __shfl_xor(bits, 4);
        bits |= __shfl_xor(bits, 8);
        if (mb2 == 0) selm[tk] = bits;
      }
#pragma unroll
      for (int rt = 0; rt < 2; ++rt)
#pragma unroll
        for (int dd = 0; dd < 4; ++dd)
          *(uint2*)(KC + (wave * 32 + rt * 16 + l15) * 128 + dd * 32 + q4 * 8) =
              make_uint2(pk2(base[rt][dd][0], base[rt][dd][1]), pk2(base[rt][dd][2], base[rt][dd][3]));
    }
    __syncthreads();
    u32 um = 0;
#pragma unroll
    for (int i = 0; i < 16; ++i) um |= selm[i];
    u32 rmask[2];
#pragma unroll
    for (int rt = 0; rt < 2; ++rt) rmask[rt] = selm[wave * 4 + rt * 2 + (l15 >> 3)];
    const int curb = t0 >> 6;
    {
      f32x4 o[2][4];
      float m[2], l[2];
#pragma unroll
      for (int rt = 0; rt < 2; ++rt) {
        m[rt] = NEGBIG; l[rt] = 0.f;
#pragma unroll
        for (int dd = 0; dd < 4; ++dd) o[rt][dd] = f32x4{0.f, 0.f, 0.f, 0.f};
      }
      u32 rem = um;
      int mb = 31 - __builtin_clz(rem);
      rem &= ~(1u << mb);
      __syncthreads();
      dma_kv_tile(proj + (size_t)(b * SEQL + mb * 64) * NSA_LD + 1280 + g * 64, NSA_LD,
                  vt + (size_t)(g * 64) * MTOK + b * SEQL + mb * 64, MTOK, smem, smem + 8192, tid);
      int bufi = 0;
      for (;;) {
        asm volatile("s_waitcnt vmcnt(0)" ::: "memory");
        __syncthreads();
        const int mbn = rem ? 31 - __builtin_clz(rem) : -1;
        if (mbn >= 0)
          dma_kv_tile(proj + (size_t)(b * SEQL + mbn * 64) * NSA_LD + 1280 + g * 64, NSA_LD,
                      vt + (size_t)(g * 64) * MTOK + b * SEQL + mbn * 64, MTOK, smem + (bufi ^ 1) * 16384,
                      smem + (bufi ^ 1) * 16384 + 8192, tid);
        const float dq0 = (float)(tokr[0] - mb * 64 - q4 * 4), dq1 = (float)(tokr[1] - mb * 64 - q4 * 4);
        const float sd0 = ((rmask[0] >> mb) & 1u) ? slope[0] * dq0 : -NEG_INF;
        const float sd1 = ((rmask[1] >> mb) & 1u) ? slope[1] * dq1 : -NEG_INF;
        if (mb < curb) {
          FSel<false> f{{dq0, dq1}, {sd0, sd1}, {slope[0], slope[1]}};
          flash_block<64, 2, true>(o, m, l, qf, smem + bufi * 16384, smem + bufi * 16384 + 8192, f);
        } else {
          FSel<true> f{{dq0, dq1}, {sd0, sd1}, {slope[0], slope[1]}};
          flash_block<64, 2, true>(o, m, l, qf, smem + bufi * 16384, smem + bufi * 16384 + 8192, f);
        }
        if (mbn < 0) break;
        rem &= ~(1u << mbn);
        mb = mbn;
        bufi ^= 1;
      }
      flash_finish_l<2>(l);
#pragma unroll
      for (int rt = 0; rt < 2; ++rt) {
        const float sc = 1.f / ((1.f + __expf(-bf2f(proj[(size_t)(b * SEQL + tokr[rt]) * NSA_LD + 1536 + 16 + head[rt]]))) * l[rt]);
#pragma unroll
        for (int dd = 0; dd < 4; ++dd) {
          uint2* bp = (uint2*)(KC + (wave * 32 + rt * 16 + l15) * 128 + dd * 32 + q4 * 8);
          const uint2 c = *bp;
          *bp = make_uint2(pk2(bflo(c.x) + o[rt][dd][0] * sc, bfhi(c.x) + o[rt][dd][1] * sc),
                           pk2(bflo(c.y) + o[rt][dd][2] * sc, bfhi(c.y) + o[rt][dd][3] * sc));
        }
      }
    }
    {
      f32x4 o[2][4];
      float m[2], l[2];
#pragma unroll
      for (int rt = 0; rt < 2; ++rt) {
        m[rt] = NEGBIG; l[rt] = 0.f;
#pragma unroll
        for (int dd = 0; dd < 4; ++dd) o[rt][dd] = f32x4{0.f, 0.f, 0.f, 0.f};
      }
      int kb0 = t0 - 511; kb0 = kb0 < 0 ? 0 : (kb0 & ~63);
      const int kb1 = t0 & ~63;
      __syncthreads();
      dma_kv_tile(proj + (size_t)(b * SEQL + kb1) * NSA_LD + 1408 + g * 64, NSA_LD,
                  vt + (size_t)(128 + g * 64) * MTOK + b * SEQL + kb1, MTOK, smem, smem + 8192, tid);
      int bufi = 0;
      for (int kb = kb1; kb >= kb0; kb -= 64) {
        asm volatile("s_waitcnt vmcnt(0)" ::: "memory");
        __syncthreads();
        if (kb - 64 >= kb0)
          dma_kv_tile(proj + (size_t)(b * SEQL + kb - 64) * NSA_LD + 1408 + g * 64, NSA_LD,
                      vt + (size_t)(128 + g * 64) * MTOK + b * SEQL + kb - 64, MTOK, smem + (bufi ^ 1) * 16384,
                      smem + (bufi ^ 1) * 16384 + 8192, tid);
        const bool full = (t0 - (kb + 63) >= 0) && (t0 + 15 - kb < 512);
        const float dq0 = (float)(tokr[0] - kb - q4 * 4), dq1 = (float)(tokr[1] - kb - q4 * 4);
        if (full) {
          FBand<false> f{{dq0, dq1}, {slope[0] * dq0, slope[1] * dq1}, {slope[0], slope[1]}, 512.f};
          flash_block<64, 2, true>(o, m, l, qf, smem + bufi * 16384, smem + bufi * 16384 + 8192, f);
        } else {
          FBand<true> f{{dq0, dq1}, {slope[0] * dq0, slope[1] * dq1}, {slope[0], slope[1]}, 512.f};
          flash_block<64, 2, true>(o, m, l, qf, smem + bufi * 16384, smem + bufi * 16384 + 8192, f);
        }
        bufi ^= 1;
      }
      flash_finish_l<2>(l);
#pragma unroll
      for (int rt = 0; rt < 2; ++rt) {
        const size_t tokg = (size_t)(b * SEQL + tokr[rt]);
        const float sc = 1.f / ((1.f + __expf(-bf2f(proj[tokg * NSA_LD + 1536 + 32 + head[rt]]))) * l[rt]);
#pragma unroll
        for (int dd = 0; dd < 4; ++dd) {
          const uint2 c = *(const uint2*)(KC + (wave * 32 + rt * 16 + l15) * 128 + dd * 32 + q4 * 8);
          float r0 = bflo(c.x) + o[rt][dd][0] * sc;
          float r1 = bfhi(c.x) + o[rt][dd][1] * sc;
          float r2 = bflo(c.y) + o[rt][dd][2] * sc;
          float r3 = bfhi(c.y) + o[rt][dd][3] * sc;
          *(uint2*)(ao + kb32(tokg, head[rt] * 64 + dd * 16 + q4 * 4, MTOK)) = make_uint2(pk2(r0, r1), pk2(r2, r3));
        }
      }
    }
  }
}

constexpr int GLA_LD = 2304;
constexpr int GQSTR = 272;
constexpr int BSTR = 129;
DEV void phase_gla_g1(const Params& p, char* smem) {
  u16* proj = (u16*)(p.ws + OFF_BIG);
  u16* ktg = (u16*)(p.ws + OFF_KT);
  u16* attb = (u16*)(p.ws + OFF_ATT);
  float* gd = (float*)(p.ws + OFF_GD);
  const float* wg2 = p.in[22];
  const float* bgate = p.in[23];
  float* b_s = (float*)smem;
  char* qe_s = smem + 33024;
  char* ke_s = qe_s + 64 * GQSTR;
  float* glr_s = (float*)(smem + 33024);
  float* w2_s = glr_s + 64 * 16;
  const int tid = otid(), lane = tid & 63, wave = tid >> 6, l15 = lane & 15, q4 = lane >> 4;
  for (int item = blockIdx.x; item < 2048; item += gridDim.x) {
    const int c = item & 31, h = (item >> 5) & 3, b = item >> 7;
    const size_t T0 = (size_t)b * SEQL + c * 64;
    __syncthreads();
    for (int i = tid; i < 64 * 16; i += 256) glr_s[i] = bf2f(proj[(T0 + (i >> 4)) * GLA_LD + 1024 + (i & 15)]);
    for (int i = tid; i < 16 * 128; i += 256) w2_s[i] = wg2[(i >> 7) * 512 + h * 128 + (i & 127)];
    __syncthreads();
    {
      const int kk = tid & 127, ih = tid >> 7;
      const float bg = bgate[h * 128 + kk];
      float wc[16];
#pragma unroll
      for (int r = 0; r < 16; ++r) wc[r] = w2_s[r * 128 + kk];
      for (int i = ih * 32; i < ih * 32 + 32; ++i) {
        float z = bg;
#pragma unroll
        for (int r = 0; r < 16; ++r) z += glr_s[i * 16 + r] * wc[r];
        const float ls = fminf(z, 0.f) - log1pf(__expf(-fabsf(z)));
        b_s[i * BSTR + kk] = ls * (1.f / 16.f);
      }
    }
    __syncthreads();
    if (tid < 128) {
      float run = 0.f;
      for (int i = 0; i < 64; ++i) { run += b_s[i * BSTR + tid]; b_s[i * BSTR + tid] = run; }
    }
    __syncthreads();
    {
      const int i = tid >> 2, k0 = (tid & 3) * 32;
      u16* qg = proj + (T0 + i) * GLA_LD + h * 128 + k0;
      const u16* kg = proj + (T0 + i) * GLA_LD + 512 + h * 128 + k0;
      const float qscale = 0.08838834764831845f;
#pragma unroll
      for (int cc = 0; cc < 4; ++cc) {
        uint4 qv = *(const uint4*)(qg + cc * 8);
        uint4 kv = *(const uint4*)(kg + cc * 8);
        u32 qw[4] = {qv.x, qv.y, qv.z, qv.w};
        u32 kw[4] = {kv.x, kv.y, kv.z, kv.w};
        u32 qo[4], ko[4];
#pragma unroll
        for (int j = 0; j < 4; ++j) {
          const int kk = k0 + cc * 8 + 2 * j;
          const float b0 = b_s[i * BSTR + kk], b1 = b_s[i * BSTR + kk + 1];
          qo[j] = pk2(bflo(qw[j]) * qscale * __expf(b0), bfhi(qw[j]) * qscale * __expf(b1));
          ko[j] = pk2(bflo(kw[j]) * __expf(-b0), bfhi(kw[j]) * __expf(-b1));
        }
        *(uint4*)(qe_s + i * GQSTR + (k0 + cc * 8) * 2) = make_uint4(qo[0], qo[1], qo[2], qo[3]);
        *(uint4*)(ke_s + i * GQSTR + (k0 + cc * 8) * 2) = make_uint4(ko[0], ko[1], ko[2], ko[3]);
        *(uint4*)(qg + cc * 8) = make_uint4(qo[0], qo[1], qo[2], qo[3]);
      }
      if (tid < 128) gd[(size_t)item * 128 + tid] = __expf(b_s[63 * BSTR + tid]);
    }
    {
      const int k = tid >> 1, j0 = (tid & 1) * 32;
      u16* kp = ktg + (size_t)(h * 128 + k) * MTOK + T0 + j0;
      const float bl = b_s[63 * BSTR + k];
#pragma unroll
      for (int cc = 0; cc < 4; ++cc) {
        uint4 kv = *(const uint4*)(kp + cc * 8);
        u32 kw[4] = {kv.x, kv.y, kv.z, kv.w};
        u32 ko[4];
#pragma unroll
        for (int j = 0; j < 4; ++j) {
          const int jj = j0 + cc * 8 + 2 * j;
          ko[j] = pk2(bflo(kw[j]) * __expf(bl - b_s[jj * BSTR + k]), bfhi(kw[j]) * __expf(bl - b_s[(jj + 1) * BSTR + k]));
        }
        *(uint4*)(kp + cc * 8) = make_uint4(ko[0], ko[1], ko[2], ko[3]);
      }
    }
    __syncthreads();
    {
      f32x4 acc[4];
#pragma unroll
      for (int jt = 0; jt < 4; ++jt) acc[jt] = f32x4{0.f, 0.f, 0.f, 0.f};
#pragma unroll
      for (int ks = 0; ks < 4; ++ks) {
        bf16x8 qfr = *(const bf16x8*)(qe_s + (wave * 16 + l15) * GQSTR + ks * 64 + q4 * 16);
#pragma unroll
        for (int jt = 0; jt < 4; ++jt) {
          bf16x8 kfr = *(const bf16x8*)(ke_s + (jt * 16 + l15) * GQSTR + ks * 64 + q4 * 16);
          acc[jt] = MFMA16(kfr, qfr, acc[jt]);
        }
      }
      const int i = wave * 16 + l15;
#pragma unroll
      for (int jt = 0; jt < 4; ++jt) {
        const int j0 = jt * 16 + q4 * 4;
        const float v0 = (j0 + 0 <= i) ? acc[jt][0] : 0.f;
        const float v1 = (j0 + 1 <= i) ? acc[jt][1] : 0.f;
        const float v2 = (j0 + 2 <= i) ? acc[jt][2] : 0.f;
        const float v3 = (j0 + 3 <= i) ? acc[jt][3] : 0.f;
        *(uint2*)(attb + ((size_t)item * 64 + i) * 64 + j0) = make_uint2(pk2(v0, v1), pk2(v2, v3));
      }
    }
  }
}

DEV void phase_gla_g2(const Params& p, char* smem) {
  const u16* proj = (const u16*)(p.ws + OFF_BIG);
  const u16* vtg = (const u16*)(p.ws + OFF_BIG + BIG_GVT);
  const u16* ktg = (const u16*)(p.ws + OFF_KT);
  const u16* attb = (const u16*)(p.ws + OFF_ATT);
  const float* gd = (const float*)(p.ws + OFF_GD);
  u16* ao = (u16*)(p.ws + OFF_AO);
  char* att_s = smem;
  char* q_s = smem + 9216;
  char* vT_s = q_s + 17408;
  char* kT_s = vT_s + 4608;
  char* sT_s = kT_s + 18432;
  const int tid = otid(), lane = tid & 63, wave = tid >> 6, l15 = lane & 15, q4 = lane >> 4;
  for (int item = blockIdx.x; item < 512; item += gridDim.x) {
    const int vs = item & 7, h = (item >> 3) & 3, b = item >> 5;
    f32x4 S[2][2];
#pragma unroll
    for (int vt = 0; vt < 2; ++vt)
#pragma unroll
      for (int kk = 0; kk < 2; ++kk) S[vt][kk] = f32x4{0.f, 0.f, 0.f, 0.f};
    uint4 ra0, ra1, rq0, rq1, rq2, rq3, rv, rk0, rk1, rk2, rk3;
    float dk0, dk1;
#define G2_LQ(i_) { const int idx_ = tid + 256 * (i_);                                                          \
      rq##i_ = *(const uint4*)(proj + (T0_ + (idx_ >> 4)) * GLA_LD + h * 128 + (idx_ & 15) * 8);                 \
      rk##i_ = *(const uint4*)(ktg + (size_t)(h * 128 + (idx_ >> 3)) * MTOK + T0_ + (idx_ & 7) * 8); }
#define G2_LOAD(c_)                                                                                              \
  {                                                                                                              \
    const size_t T0_ = (size_t)b * SEQL + (c_) * 64;                                                             \
    const size_t ci_ = (size_t)((b * 4 + h) * 32 + (c_));                                                        \
    ra0 = *(const uint4*)(attb + ci_ * 4096 + (size_t)(tid) * 8);                                              \
    ra1 = *(const uint4*)(attb + ci_ * 4096 + (size_t)(tid + 256) * 8);                                        \
    G2_LQ(0) G2_LQ(1) G2_LQ(2) G2_LQ(3)                                                                          \
    rv = *(const uint4*)(vtg + (size_t)(h * 256 + vs * 32 + (tid >> 3)) * MTOK + T0_ + (tid & 7) * 8);           \
    dk0 = gd[ci_ * 128 + (2 * wave) * 16 + l15];                                                                \
    dk1 = gd[ci_ * 128 + (2 * wave + 1) * 16 + l15];                                                            \
  }
    G2_LOAD(0);
    for (int c = 0; c < 32; ++c) {
      const size_t T0 = (size_t)b * SEQL + c * 64;
      __syncthreads();
#define G2_ST(i_) { const int idx = tid + 256 * (i_);                                       \
        *(uint4*)(q_s + (idx >> 4) * GQSTR + (idx & 15) * 16) = rq##i_;                     \
        *(uint4*)(kT_s + (idx >> 3) * 144 + (idx & 7) * 16) = rk##i_; }
      *(uint4*)(att_s + (tid >> 3) * 144 + (tid & 7) * 16) = ra0;
      *(uint4*)(att_s + ((tid + 256) >> 3) * 144 + (tid & 7) * 16) = ra1;
      G2_ST(0) G2_ST(1) G2_ST(2) G2_ST(3)
#undef G2_ST
      *(uint4*)(vT_s + (tid >> 3) * 144 + (tid & 7) * 16) = rv;
#pragma unroll
      for (int vt = 0; vt < 2; ++vt)
#pragma unroll
        for (int kk = 0; kk < 2; ++kk)
#pragma unroll
          for (int jj = 0; jj < 4; ++jj)
            *(u16*)(sT_s + (vt * 16 + q4 * 4 + jj) * GQSTR + ((2 * wave + kk) * 16 + l15) * 2) = f2bf(S[vt][kk][jj]);
      const float d0 = dk0, d1 = dk1;
      __syncthreads();
      if (c + 1 < 32) G2_LOAD(c + 1);
      f32x4 o[2];
      o[0] = f32x4{0.f, 0.f, 0.f, 0.f}; o[1] = o[0];
#pragma unroll
      for (int ks = 0; ks < 2; ++ks) {
        bf16x8 bfr = *(const bf16x8*)(att_s + (wave * 16 + l15) * 144 + ks * 64 + q4 * 16);
#pragma unroll
        for (int vt = 0; vt < 2; ++vt) {
          bf16x8 afr = *(const bf16x8*)(vT_s + (vt * 16 + l15) * 144 + ks * 64 + q4 * 16);
          o[vt] = MFMA16(afr, bfr, o[vt]);
        }
      }
#pragma unroll
      for (int ks = 0; ks < 4; ++ks) {
        bf16x8 bfr = *(const bf16x8*)(q_s + (wave * 16 + l15) * GQSTR + ks * 64 + q4 * 16);
#pragma unroll
        for (int vt = 0; vt < 2; ++vt) {
          bf16x8 afr = *(const bf16x8*)(sT_s + (vt * 16 + l15) * GQSTR + ks * 64 + q4 * 16);
          o[vt] = MFMA16(afr, bfr, o[vt]);
        }
      }
#pragma unroll
      for (int vt = 0; vt < 2; ++vt)
        *(uint2*)(ao + kb32(T0 + wave * 16 + l15, h * 256 + vs * 32 + vt * 16 + q4 * 4, MTOK)) =
            make_uint2(pk2(o[vt][0], o[vt][1]), pk2(o[vt][2], o[vt][3]));
#pragma unroll
      for (int vt = 0; vt < 2; ++vt) {
        S[vt][0][0] *= d0; S[vt][0][1] *= d0; S[vt][0][2] *= d0; S[vt][0][3] *= d0;
        S[vt][1][0] *= d1; S[vt][1][1] *= d1; S[vt][1][2] *= d1; S[vt][1][3] *= d1;
      }
#pragma unroll
      for (int ks = 0; ks < 2; ++ks) {
        bf16x8 afr[2];
#pragma unroll
        for (int vt = 0; vt < 2; ++vt) afr[vt] = *(const bf16x8*)(vT_s + (vt * 16 + l15) * 144 + ks * 64 + q4 * 16);
#pragma unroll
        for (int kk = 0; kk < 2; ++kk) {
          bf16x8 bfr = *(const bf16x8*)(kT_s + ((2 * wave + kk) * 16 + l15) * 144 + ks * 64 + q4 * 16);
#pragma unroll
          for (int vt = 0; vt < 2; ++vt) S[vt][kk] = MFMA16(afr[vt], bfr, S[vt][kk]);
        }
      }
    }
#undef G2_LOAD
#undef G2_LQ
  }
}

DEV void phase_gla_g3(const Params& p) {
  const u16* proj = (const u16*)(p.ws + OFF_BIG);
  u16* ao = (u16*)(p.ws + OFF_AO);
  const float* ng = p.in[24];
  const int wave = otid() >> 6, lane = otid() & 63;
  for (int th = blockIdx.x * 4 + wave; th < MTOK * 4; th += gridDim.x * 4) {
    const size_t tok = th >> 2; const int h = th & 3;
    u16* op = ao + kb32(tok, h * 256 + lane * 4, MTOK);
    uint2 v = *(const uint2*)op;
    float x0 = bflo(v.x), x1 = bfhi(v.x), x2 = bflo(v.y), x3 = bfhi(v.y);
    float ss = x0 * x0 + x1 * x1 + x2 * x2 + x3 * x3;
#pragma unroll
    for (int o = 32; o > 0; o >>= 1) ss += __shfl_xor(ss, o);
    const float rs = rsqrtf(ss * (1.f / 256.f) + 1e-5f);
    uint2 rv = *(const uint2*)(proj + tok * GLA_LD + 1040 + h * 256 + lane * 4);
    float4 gg = *(const float4*)(ng + lane * 4);
    float r0 = bflo(rv.x), r1 = bfhi(rv.x), r2 = bflo(rv.y), r3 = bfhi(rv.y);
    float y0 = x0 * rs * gg.x * (r0 / (1.f + __expf(-r0)));
    float y1 = x1 * rs * gg.y * (r1 / (1.f + __expf(-r1)));
    float y2 = x2 * rs * gg.z * (r2 / (1.f + __expf(-r2)));
    float y3 = x3 * rs * gg.w * (r3 / (1.f + __expf(-r3)));
    *(uint2*)op = make_uint2(pk2(y0, y1), pk2(y2, y3));
  }
}

DEV void phase_pool_diff(const Params& p) {
  u16* ao = (u16*)(p.ws + OFF_AO);
  const size_t nitems = (size_t)(MTOK / 16) * 256;
  for (size_t i = (size_t)blockIdx.x * NTHREADS + otid(); i < nitems; i += (size_t)gridDim.x * NTHREADS) {
    const int c = (int)(i & 255) * 4;
    const size_t tok0 = (i >> 8) * 16;
    const int t0 = (int)(tok0 & (SEQL - 1));
    const int w = 2 << (c >> 8);
    const float* xp = p.xf + tok0 * 1024 + c;
    float4 s = make_float4(0.f, 0.f, 0.f, 0.f);
    for (int j = w - 1; j >= 1; --j) {
      if (t0 - j >= 0) {
        float4 v = *(const float4*)(xp - (size_t)j * 1024);
        s.x += v.x; s.y += v.y; s.z += v.z; s.w += v.w;
      }
    }
    for (int k = 0; k < 16; ++k) {
      const int t = t0 + k;
      float4 x0 = *(const float4*)(xp + (size_t)k * 1024);
      s.x += x0.x; s.y += x0.y; s.z += x0.z; s.w += x0.w;
      const int cntw = (t + 1 < w) ? (t + 1) : w;
      const float inv = 1.f / (float)cntw;
      *(uint2*)(ao + kb32(tok0 + k, c, MTOK)) =
          make_uint2(pk2(s.x * inv - x0.x, s.y * inv - x0.y), pk2(s.z * inv - x0.z, s.w * inv - x0.w));
      if (t - (w - 1) >= 0) {
        float4 v = *(const float4*)(xp + (size_t)(k - (w - 1)) * 1024);
        s.x -= v.x; s.y -= v.y; s.z -= v.z; s.w -= v.w;
      }
    }
  }
}

__global__ void __launch_bounds__(NTHREADS, 2) fwd_megakernel(Params p, int ph_lo, int ph_hi) {
  extern __shared__ __attribute__((aligned(16))) char smem[];
  cg::grid_group grid = cg::this_grid();
  int ph = 0;
  volatile unsigned* bst = (volatile unsigned*)(smem + SMEM_BYTES - 16);
  if (threadIdx.x == 0) { bst[0] = 0u; bst[1] = 0u; }
  __syncthreads();
  XcdBarrier gbar = xcd_barrier_post((unsigned*)(p.ws + OFF_BAR), bst);
  u16* wt = (u16*)(p.ws + OFF_WT);
  u16* xb = (u16*)(p.ws + OFF_XB);
  u16* big = (u16*)(p.ws + OFF_BIG);
  u16* ao = (u16*)(p.ws + OFF_AO);
  unsigned long long* lnslots = (unsigned long long*)(p.ws + OFF_LNX);
  unsigned* lnflags = (unsigned*)(p.ws + OFF_LNF);
#define PHASE(...)                                    \
  {                                                   \
    if (ph >= ph_lo && ph < ph_hi) {                  \
      if (ph > ph_lo) xcd_barrier(gbar);              \
      __VA_ARGS__;                                    \
    }                                                 \
    ++ph;                                             \
  }
  PHASE({ phase_init(p); phase_conv_weights(p, 0, smem); });
  for (int L = 0; L < 4; ++L) {
    const float* lng = p.in[2] + (size_t)L * 4096;
    const float* lnb = p.in[3] + (size_t)L * 4096;
    PHASE({ int base = 0; EpiArgs ea{big, FF, 1.f, nullptr};
            gemm_job<1>(base, wt + W_GU1, 5632, 22, xb, MTOK, 256, 1024, false, ea, smem); });
    PHASE({ int base = 0;
            EpiArgs ea{nullptr, 0, 0.5f, nullptr, L == 0 ? p.in[0] : p.xf, p.xf, xb, lng, lnb, lnslots, lnflags + (L * 4 + 0) * 256};
            gemm_job<4>(base, wt + W_D1, 1024, 4, big, MTOK, 256, FF, false, ea, smem); });
    if (L == 0) {
      PHASE({ int base = 0;
              EpiArgs ea{big, 1280, 1.f, nullptr};
              gemm_job<0>(base, wt + W_MIN, 1536, 5, xb, MTOK, 256, 1024, false, ea, smem);
              EpiArgs eb{(char*)big + BIG_VT2, MTOK, 1.f, nullptr};
              gemm_job<0>(base, xb, MTOK, 128, wt + W_MIN + 1280ull * 32, 1536, 2, 1024, true, eb, smem); });
      PHASE(phase_swa_attn(p, smem));
    } else if (L == 1) {
      PHASE({ int base = 0;
              EpiArgs ea{big, NSA_LD, 1.f, nullptr};
              gemm_job<0>(base, wt + W_MIN, 2048, 7, xb, MTOK, 256, 1024, false, ea, smem);
              EpiArgs eb{(char*)big + BIG_VT2, MTOK, 1.f, nullptr};
              gemm_job<0>(base, xb, MTOK, 128, wt + W_MIN + 1792ull * 32, 2048, 2, 1024, true, eb, smem); });
      PHASE(phase_nsa_compress(p, smem));
      PHASE(phase_nsa_attn(p, smem));
    } else if (L == 2) {
      PHASE({ int base = 0; EpiArgs ea{big, GLA_LD, 1.f, nullptr};
              gemm_job<0>(base, wt + W_MIN, 3328, 9, xb, MTOK, 256, 1024, false, ea, smem);
              EpiArgs ev{(char*)big + BIG_GVT, MTOK, 1.f, nullptr};
              gemm_job<0>(base, xb, MTOK, 128, wt + W_MIN + 2304ull * 32, 3328, 8, 1024, true, ev, smem);
              EpiArgs ek{p.ws + OFF_KT, MTOK, 1.f, nullptr};
              gemm_job<0>(base, xb, MTOK, 128, wt + W_MIN + 512ull * 32, 3328, 4, 1024, true, ek, smem); });
      PHASE(phase_gla_g1(p, smem));
      PHASE(phase_gla_g2(p, smem));
      PHASE(phase_gla_g3(p));
    } else {
      PHASE(phase_pool_diff(p));
    }
    if (L < 3) {
      PHASE({ int base = 0;
              EpiArgs ea{nullptr, 0, 1.f, nullptr, p.xf, p.xf, xb, lng + 1024, lnb + 1024, lnslots, lnflags + (L * 4 + 1) * 256};
              gemm_job<4>(base, wt + W_MOUT, 1024, 4, ao, MTOK, 256, 1024, false, ea, smem); });
    } else {
      PHASE({ int base = 0;
              EpiArgs ea{nullptr, 0, 1.f, nullptr, p.xf, p.xf, xb, lng + 1024, lnb + 1024, lnslots, lnflags + (L * 4 + 1) * 256};
              gemm_job<4>(base, wt + W_MIN, 1024, 4, ao, MTOK, 256, 256, false, ea, smem, (size_t)8 * MTOK * 32); });
    }
    PHASE({ int base = 0;
            EpiArgs ea{big, 1024, 1.f, nullptr};
            gemm_job<0>(base, wt + W_XQ, 1024, 4, xb, MTOK, 256, 1024, false, ea, smem);
            EpiArgs ek{p.ws + OFF_KB, 1024, 1.f, nullptr};
            gemm_job<0>(base, wt + W_XKV, 2048, 4, (const u16*)(p.ws + OFF_MEMB), 4096, 32, 1024, false, ek, smem);
            EpiArgs ev{p.ws + OFF_VT, 4096, 1.f, nullptr};
            gemm_job<0>(base, (const u16*)(p.ws + OFF_MEMB), 4096, 16, wt + W_XKV + 1024ull * 32, 2048, 8, 1024, true, ev, smem); });
    PHASE(phase_xattn(p, smem));
    PHASE({ int base = 0;
            EpiArgs ea{nullptr, 0, 1.f, nullptr, p.xf, p.xf, xb, lng + 2048, lnb + 2048, lnslots, lnflags + (L * 4 + 2) * 256};
            gemm_job<4>(base, wt + W_XO, 1024, 4, ao, MTOK, 256, 1024, false, ea, smem); });
    PHASE({ int base = 0; EpiArgs ea{big, FF, 1.f, nullptr};
            gemm_job<1>(base, wt + W_GU2, 5632, 22, xb, MTOK, 256, 1024, false, ea, smem); });
    PHASE({ int base = 0;
            EpiArgs ea{nullptr, 0, 0.5f, nullptr, p.xf, p.xf, xb, lng + 3072, lnb + 3072, lnslots, lnflags + (L * 4 + 3) * 256};
            gemm_job<4>(base, wt + W_D2, 1024, 4, big, MTOK, 256, FF, false, ea, smem); });
    if (L < 3) PHASE(phase_conv_weights(p, L + 1, smem));
  }
  if (ph_hi == -12345) grid.sync();
#undef PHASE
}

constexpr int N_PHASES = 1 << 20;

#ifndef MULTI_LAUNCH
#define MULTI_LAUNCH 0
#endif

extern "C" void kernel_launch(void* const* d_in, const int* in_sizes, int n_in, void* d_out, int out_size, void* d_ws,
                              size_t ws_size, hipStream_t stream) {
  static int grid_blocks = 0;
  if (!grid_blocks) {
    hipFuncSetAttribute((const void*)fwd_megakernel, hipFuncAttributeMaxDynamicSharedMemorySize, SMEM_BYTES);
    int dev = 0, cus = 0, per_cu = 0;
    hipGetDevice(&dev);
    hipDeviceGetAttribute(&cus, hipDeviceAttributeMultiprocessorCount, dev);
    hipOccupancyMaxActiveBlocksPerMultiprocessor(&per_cu, fwd_megakernel, NTHREADS, SMEM_BYTES);
    if (per_cu > 2) per_cu = 2;
    if (per_cu < 1) per_cu = 1;
    grid_blocks = cus * per_cu;
  }
  Params p{};
  for (int i = 0; i < 28; ++i) p.in[i] = (const float*)d_in[i];
  p.xf = (float*)d_out;
  p.ws = (char*)d_ws;
#if MULTI_LAUNCH
  for (int ph = 0; ph < N_PHASES; ++ph) {
    hipLaunchKernelGGL(fwd_megakernel, dim3(grid_blocks), dim3(NTHREADS), SMEM_BYTES, stream, p, ph, ph + 1);
  }
#else
  hipMemsetAsync((char*)d_ws + OFF_BAR, 0, 32768, stream);
  int lo = 0, hi = N_PHASES;
  void* args[] = {&p, &lo, &hi};
  hipError_t e = hipLaunchCooperativeKernel((const void*)fwd_megakernel, dim3(grid_blocks), dim3(NTHREADS), args,
                                            SMEM_BYTES, stream);
  if (e != hipSuccess) fprintf(stderr, "cooperative launch failed: %s (grid %d)\n", hipGetErrorString(e), grid_blocks);
#endif
}
```
